# Optimizing an MI355X kernel written in HIP

```python
import math
import jax, jax.numpy as jnp
from jax import lax
import numpy as np

D_MODEL = 1024
BATCH = 8
SEQ = 4096
DEPTH = 1

HEAD_DIM = 64
ROPE_DIMS = HEAD_DIM // 4
ROPE_THETA = 500000.0
NORM_EPS = 1e-6
NEG_INF = -1e30

NSA_HEADS = 8
NSA_KV_GROUPS = 2
NSA_Q_PER_KV = NSA_HEADS // NSA_KV_GROUPS
CMP_BLOCK = 32
CMP_STRIDE = 16
CMP_HIDDEN = 256
SLC_BLOCK = 64
SLC_TOPN = 16
FORCE_SCORE = 1e3
WIN = 512
NSA_QBLOCK = 64

DIL_PATTERNS = ((128, 1), (512, 4), (2048, 16))
DIL_GROUPS = len(DIL_PATTERNS)
DIL_HEADS_PER_GROUP = 4
DIL_WIDTH = DIL_HEADS_PER_GROUP * HEAD_DIM
DIL_BLOCK = 128

NSA_Q_COLS = NSA_HEADS * HEAD_DIM
NSA_KV_COLS = NSA_KV_GROUPS * HEAD_DIM
NSA_GATE_COLS = 3 * NSA_HEADS
DIL_COLS = DIL_GROUPS * 3 * DIL_WIDTH
MERGE_COLS = 2 * D_MODEL
IN_COLS = NSA_Q_COLS + 6 * NSA_KV_COLS + NSA_GATE_COLS + DIL_COLS + MERGE_COLS

PEER_HEADS = 8
PEER_NKEYS = 128
PEER_TOPK = 16
PEER_QDIM = 128
PEER_N_EXPERTS = PEER_NKEYS ** 2
PEER_CHUNK = 128

kernel_name = "hybrid_nsa_dilated_peer_block"


def rms_norm(z, g):
    zf = z.astype(jnp.float32)
    zf = zf * lax.rsqrt(jnp.mean(zf * zf, axis=-1, keepdims=True) + NORM_EPS)
    return (zf * g.astype(jnp.float32)).astype(z.dtype)


def rope(z, pos):
    half = ROPE_DIMS // 2
    inv = ROPE_THETA ** (-(jnp.arange(half, dtype=jnp.float32) * 2.0 / ROPE_DIMS))
    ang = pos.astype(jnp.float32)[:, None] * inv[None, :]
    cos = jnp.cos(ang)[None, :, None, :]
    sin = jnp.sin(ang)[None, :, None, :]
    zf = z.astype(jnp.float32)
    z1 = zf[..., :half]
    z2 = zf[..., half:ROPE_DIMS]
    out = jnp.concatenate([z1 * cos - z2 * sin, z1 * sin + z2 * cos, zf[..., ROPE_DIMS:]], axis=-1)
    return out.astype(z.dtype)


def compress_blocks(z, idx, pe, w1, w2):
    B, _, G, dh = z.shape
    blk = z[:, idx] + pe[None, None, :, None, :]
    n_cmp = idx.shape[0]
    flat = blk.transpose(0, 1, 3, 2, 4).reshape(B, n_cmp, G, CMP_BLOCK * dh)
    return jax.nn.gelu(flat @ w1) @ w2


def nsa_attention(q, k_c, v_c, k_s, v_s, k_w, v_w, gate_logits, q_norm, k_norm,
                  cmp_pe_k, cmp_w1_k, cmp_w2_k, cmp_pe_v, cmp_w1_v, cmp_w2_v):
    B, S, _ = q.shape
    G, HG, dh = NSA_KV_GROUPS, NSA_Q_PER_KV, HEAD_DIM
    scale = HEAD_DIM ** -0.5
    dtype = q.dtype
    pos = jnp.arange(S, dtype=jnp.int32)
    q = rope(rms_norm(q.reshape(B, S, NSA_HEADS, dh), q_norm), pos)
    shp = (B, S, G, dh)
    k_s = rope(rms_norm(k_s.reshape(shp), k_norm[1]), pos)
    k_w = rope(rms_norm(k_w.reshape(shp), k_norm[2]), pos)
    v_s = v_s.reshape(shp)
    v_w = v_w.reshape(shp)

    n_cmp = (S - CMP_BLOCK) // CMP_STRIDE + 1
    starts = jnp.arange(n_cmp, dtype=jnp.int32) * CMP_STRIDE
    idx = starts[:, None] + jnp.arange(CMP_BLOCK, dtype=jnp.int32)[None, :]
    cmp_end = starts + CMP_BLOCK - 1
    k_cmp = compress_blocks(k_c.reshape(shp), idx, cmp_pe_k, cmp_w1_k, cmp_w2_k)
    v_cmp = compress_blocks(v_c.reshape(shp), idx, cmp_pe_v, cmp_w1_v, cmp_w2_v)
    k_cmp = rope(rms_norm(k_cmp, k_norm[0]), cmp_end)

    n_slc = S // SLC_BLOCK
    n_sel = min(SLC_TOPN, n_slc)
    s0 = np.arange(n_cmp) * CMP_STRIDE
    s1 = s0 + CMP_BLOCK
    b0 = np.arange(n_slc) * SLC_BLOCK
    b1 = b0 + SLC_BLOCK
    ov = np.clip(np.minimum(s1[:, None], b1[None, :]) - np.maximum(s0[:, None], b0[None, :]), 0, None) / CMP_BLOCK
    overlap = jnp.asarray(ov, dtype=jnp.float32)

    ks_blk = k_s.reshape(B, n_slc, SLC_BLOCK, G, dh).transpose(0, 3, 1, 2, 4)
    vs_blk = v_s.reshape(B, n_slc, SLC_BLOCK, G, dh).transpose(0, 3, 1, 2, 4)
    kw_pad = jnp.pad(k_w, ((0, 0), (WIN, 0), (0, 0), (0, 0)))
    vw_pad = jnp.pad(v_w, ((0, 0), (WIN, 0), (0, 0), (0, 0)))
    gates = jax.nn.sigmoid(gate_logits.astype(jnp.float32)).reshape(B, S, NSA_HEADS, 3)
    bi = jnp.arange(B)[:, None, None, None]
    gi = jnp.arange(G)[None, :, None, None]
    blk_ids = jnp.arange(n_slc, dtype=jnp.int32)
    QB = NSA_QBLOCK

    def body(n):
        t0 = n * QB
        t = t0 + jnp.arange(QB, dtype=jnp.int32)
        qb = lax.dynamic_slice_in_dim(q, t0, QB, axis=1).reshape(B, QB, G, HG, dh)
        sc = jnp.einsum('bqgjd,bcgd->bgjqc', qb, k_cmp).astype(jnp.float32) * scale
        valid_c = cmp_end[None, :] <= t[:, None]
        pc = jax.nn.softmax(jnp.where(valid_c, sc, NEG_INF), axis=-1)
        pc = jnp.where(valid_c, pc, 0.0)
        o_c = jnp.einsum('bgjqc,bcgd->bqgjd', pc.astype(dtype), v_cmp)
        imp = jnp.einsum('bgjqc,cn->bgqn', pc, overlap)
        cur = t // SLC_BLOCK
        forced = (blk_ids[None, :] == 0) | (blk_ids[None, :] == cur[:, None]) | (blk_ids[None, :] == cur[:, None] - 1)
        causal_b = blk_ids[None, :] * SLC_BLOCK <= t[:, None]
        score = jnp.where(forced, FORCE_SCORE, jnp.where(causal_b, imp, -1.0))
        _, sel = lax.top_k(score, n_sel)
        kg = ks_blk[bi, gi, sel]
        vg = vs_blk[bi, gi, sel]
        ss = jnp.einsum('bqgjd,bgqnkd->bgjqnk', qb, kg).astype(jnp.float32) * scale
        kpos = sel[..., None] * SLC_BLOCK + jnp.arange(SLC_BLOCK, dtype=jnp.int32)
        valid_s = kpos <= t[None, None, :, None, None]
        ss = jnp.where(valid_s[:, :, None], ss, NEG_INF).reshape(B, G, HG, QB, n_sel * SLC_BLOCK)
        ps = jax.nn.softmax(ss, axis=-1).reshape(B, G, HG, QB, n_sel, SLC_BLOCK)
        o_s = jnp.einsum('bgjqnk,bgqnkd->bqgjd', ps.astype(dtype), vg)
        kwb = lax.dynamic_slice_in_dim(kw_pad, t0, QB + WIN, axis=1)
        vwb = lax.dynamic_slice_in_dim(vw_pad, t0, QB + WIN, axis=1)
        kp = t0 - WIN + jnp.arange(QB + WIN, dtype=jnp.int32)
        dist = t[:, None] - kp[None, :]
        valid_w = (dist >= 0) & (dist < WIN) & (kp[None, :] >= 0)
        sw = jnp.einsum('bqgjd,bkgd->bgjqk', qb, kwb).astype(jnp.float32) * scale
        pw = jax.nn.softmax(jnp.where(valid_w, sw, NEG_INF), axis=-1)
        o_w = jnp.einsum('bgjqk,bkgd->bqgjd', pw.astype(dtype), vwb)
        gb = lax.dynamic_slice_in_dim(gates, t0, QB, axis=1).reshape(B, QB, G, HG, 3)
        o = gb[..., 0:1] * o_c + gb[..., 1:2] * o_s + gb[..., 2:3] * o_w
        return o.reshape(B, QB, NSA_HEADS * dh).astype(dtype)

    out = lax.map(body, jnp.arange(S // QB, dtype=jnp.int32))
    return out.transpose(1, 0, 2, 3).reshape(B, S, NSA_HEADS * dh)


def dilated_group(q, k, v, window, dilation):
    B, S, H, dh = q.shape
    scale = HEAD_DIM ** -0.5
    n_back = window // dilation
    L = -(-S // dilation)
    L = -(-L // DIL_BLOCK) * DIL_BLOCK
    Sp = L * dilation
    nb = L // DIL_BLOCK
    pad = ((0, 0), (0, Sp - S), (0, 0), (0, 0))

    def to_blocks(z):
        z = jnp.pad(z, pad).reshape(B, L, dilation, H, dh).transpose(0, 2, 3, 1, 4)
        return z.reshape(B, dilation, H, nb, DIL_BLOCK, dh)

    def with_prev(z):
        prev = jnp.pad(z[:, :, :, :-1], ((0, 0), (0, 0), (0, 0), (1, 0), (0, 0), (0, 0)))
        return jnp.concatenate([prev, z], axis=4)

    qb = to_blocks(q)
    kk = with_prev(to_blocks(k))
    vv = with_prev(to_blocks(v))
    s = jnp.einsum('brhnqd,brhnkd->brhnqk', qb, kk).astype(jnp.float32) * scale
    blk = jnp.arange(nb, dtype=jnp.int32)[:, None]
    pq = blk * DIL_BLOCK + jnp.arange(DIL_BLOCK, dtype=jnp.int32)[None, :]
    pk = (blk - 1) * DIL_BLOCK + jnp.arange(2 * DIL_BLOCK, dtype=jnp.int32)[None, :]
    dist = pq[:, :, None] - pk[:, None, :]
    valid = (dist >= 0) & (dist <= n_back) & (pk[:, None, :] >= 0)
    s = jnp.where(valid, s, NEG_INF)
    m = jnp.max(s, axis=-1, keepdims=True)
    e = jnp.exp(s - m)
    den = jnp.sum(e, axis=-1)
    o = jnp.einsum('brhnqk,brhnkd->brhnqd', e, vv.astype(jnp.float32)) / den[..., None]
    lse = m[..., 0] + jnp.log(den)
    o = o.reshape(B, dilation, H, L, dh).transpose(0, 3, 1, 2, 4).reshape(B, Sp, H, dh)[:, :S]
    lse = lse.reshape(B, dilation, H, L).transpose(0, 3, 1, 2).reshape(B, Sp, H)[:, :S]
    return o, lse


def dilated_attention(d_cols, q_norm, k_norm):
    B, S, _ = d_cols.shape
    pos = jnp.arange(S, dtype=jnp.int32)
    d = d_cols.reshape(B, S, DIL_GROUPS, 3, DIL_HEADS_PER_GROUP, HEAD_DIM)
    outs, lses = [], []
    for g, (window, dilation) in enumerate(DIL_PATTERNS):
        qg = rope(rms_norm(d[:, :, g, 0], q_norm[g]), pos)
        kg = rope(rms_norm(d[:, :, g, 1], k_norm[g]), pos)
        o, lse = dilated_group(qg, kg, d[:, :, g, 2], window, dilation)
        outs.append(o)
        lses.append(lse)
    alpha = jax.nn.softmax(jnp.stack(lses, axis=0), axis=0)
    o = jnp.sum(alpha[..., None] * jnp.stack(outs, axis=0), axis=0)
    return o.reshape(B, S, DIL_WIDTH).astype(d_cols.dtype)


def peer(hn, w_q, subkeys, u, v):
    B, S, D = hn.shape
    T = B * S
    H, K = PEER_HEADS, PEER_TOPK
    xt = hn.reshape(T, D)
    q = (xt @ w_q).reshape(T, H, 2, PEER_QDIM // 2)
    s = jnp.einsum('thcd,cnd->thcn', q, subkeys).astype(jnp.float32)
    s1, i1 = lax.top_k(s[:, :, 0], K)
    s2, i2 = lax.top_k(s[:, :, 1], K)
    cand = (s1[..., :, None] + s2[..., None, :]).reshape(T, H, K * K)
    sc, ci = lax.top_k(cand, K)
    e1 = jnp.take_along_axis(i1, ci // K, axis=-1)
    e2 = jnp.take_along_axis(i2, ci % K, axis=-1)
    idx = e1 * PEER_NKEYS + e2
    g = jax.nn.softmax(sc, axis=-1)
    C = PEER_CHUNK
    nc = T // C

    def body(args):
        xc, ic, gc = args
        a = jnp.einsum('cd,chkd->chk', xc, u[ic])
        act = (jax.nn.gelu(a.astype(jnp.float32)) * gc).astype(xc.dtype)
        return jnp.einsum('chk,chkd->cd', act, v[ic])

    out = lax.map(body, (xt.reshape(nc, C, D), idx.reshape(nc, C, H, K), g.reshape(nc, C, H, K)))
    return out.reshape(B, S, D)


def setup_inputs(seed: int = 0) -> dict:
    key = jax.random.key(seed)
    ks = jax.random.split(key, 24)
    f32 = jnp.float32

    def nrm(k, shape, scale):
        return jax.random.normal(k, shape, f32) * scale

    def gain(k, shape):
        return 1.0 + 0.02 * jax.random.normal(k, shape, f32)

    flat = CMP_BLOCK * HEAD_DIM
    nsa_w = NSA_HEADS * HEAD_DIM
    return {
        "x": nrm(ks[0], (BATCH, SEQ, D_MODEL), 1.0),
        "norm1_g": gain(ks[1], (D_MODEL,)),
        "w_in": nrm(ks[2], (D_MODEL, IN_COLS), D_MODEL ** -0.5),
        "nsa_q_norm": gain(ks[3], (HEAD_DIM,)),
        "nsa_k_norm": gain(ks[4], (3, HEAD_DIM)),
        "cmp_pe_k": nrm(ks[5], (CMP_BLOCK, HEAD_DIM), 0.1),
        "cmp_w1_k": nrm(ks[6], (flat, CMP_HIDDEN), flat ** -0.5),
        "cmp_w2_k": nrm(ks[7], (CMP_HIDDEN, HEAD_DIM), CMP_HIDDEN ** -0.5),
        "cmp_pe_v": nrm(ks[8], (CMP_BLOCK, HEAD_DIM), 0.1),
        "cmp_w1_v": nrm(ks[9], (flat, CMP_HIDDEN), flat ** -0.5),
        "cmp_w2_v": nrm(ks[10], (CMP_HIDDEN, HEAD_DIM), CMP_HIDDEN ** -0.5),
        "dil_q_norm": gain(ks[11], (DIL_GROUPS, HEAD_DIM)),
        "dil_k_norm": gain(ks[12], (DIL_GROUPS, HEAD_DIM)),
        "w_up_nsa": nrm(ks[13], (nsa_w, D_MODEL), nsa_w ** -0.5),
        "w_up_dil": nrm(ks[14], (DIL_WIDTH, D_MODEL), DIL_WIDTH ** -0.5),
        "w_o": nrm(ks[15], (D_MODEL, D_MODEL), D_MODEL ** -0.5),
        "norm2_g": gain(ks[16], (D_MODEL,)),
        "peer_wq": nrm(ks[17], (D_MODEL, PEER_HEADS * PEER_QDIM), D_MODEL ** -0.5),
        "peer_subkeys": nrm(ks[18], (2, PEER_NKEYS, PEER_QDIM // 2), (PEER_QDIM // 2) ** -0.5),
        "peer_u": nrm(ks[19], (PEER_N_EXPERTS, D_MODEL), D_MODEL ** -0.5),
        "peer_v": nrm(ks[20], (PEER_N_EXPERTS, D_MODEL), PEER_HEADS ** -0.5),
    }


def reference(x, norm1_g, w_in, nsa_q_norm, nsa_k_norm, cmp_pe_k, cmp_w1_k, cmp_w2_k,
              cmp_pe_v, cmp_w1_v, cmp_w2_v, dil_q_norm, dil_k_norm, w_up_nsa, w_up_dil,
              w_o, norm2_g, peer_wq, peer_subkeys, peer_u, peer_v):
    B, S, D = x.shape
    sizes = [NSA_Q_COLS] + [NSA_KV_COLS] * 6 + [NSA_GATE_COLS, DIL_COLS, MERGE_COLS]
    splits = [int(c) for c in np.cumsum(sizes)[:-1]]
    for _ in range(DEPTH):
        h = rms_norm(x, norm1_g)
        z = jnp.einsum('bsd,dc->bsc', h, w_in)
        q_n, kc, vc, ksl, vsl, kwn, vwn, g_nsa, dil, mg = jnp.split(z, splits, axis=-1)
        y_nsa = nsa_attention(q_n, kc, vc, ksl, vsl, kwn, vwn, g_nsa, nsa_q_norm, nsa_k_norm,
                              cmp_pe_k, cmp_w1_k, cmp_w2_k, cmp_pe_v, cmp_w1_v, cmp_w2_v)
        y_dil = dilated_attention(dil, dil_q_norm, dil_k_norm)
        gm = jax.nn.sigmoid(mg.astype(jnp.float32)).reshape(B, S, 2, D)
        merged = gm[:, :, 0] * (y_nsa @ w_up_nsa) + gm[:, :, 1] * (y_dil @ w_up_dil)
        x = x + merged.astype(x.dtype) @ w_o
        x = x + peer(rms_norm(x, norm2_g), peer_wq, peer_subkeys, peer_u, peer_v)
    return x
```

```cpp
#include <hip/hip_runtime.h>
#include <hip/hip_cooperative_groups.h>
#include <cstdio>
#include <cstdint>
namespace cg = cooperative_groups;

typedef unsigned short bf16_t;
typedef short bf16x8 __attribute__((ext_vector_type(8)));
typedef float f32x4 __attribute__((ext_vector_type(4)));
typedef float f32x16 __attribute__((ext_vector_type(16)));
typedef unsigned u32x4 __attribute__((ext_vector_type(4)));
typedef unsigned u32x2 __attribute__((ext_vector_type(2)));
#define LAS __attribute__((address_space(3)))

constexpr int B_ = 8, S_ = 4096, D_ = 1024, T_ = B_ * S_;
constexpr int HD = 64;
constexpr int IN_COLS = 5656, NIN = 5632;
constexpr int NCMP = 255;
constexpr float C2 = 0.125f * 1.4426950408889634f;
constexpr float EPS = 1e-6f;
constexpr int YP = 768;

constexpr size_t MiB = 1u << 20;
constexpr size_t WS_CTL = 0;
constexpr size_t WS_WTIN = 1 * MiB;
constexpr size_t WS_WTCAT = 12 * MiB;
constexpr size_t WS_WTO = 14 * MiB;
constexpr size_t WS_WTQ = 16 * MiB;
constexpr size_t WS_WTC1K = 18 * MiB;
constexpr size_t WS_WTC1V = 19 * MiB;
constexpr size_t WS_MISC = 20 * MiB;
constexpr size_t WS_ROPE = WS_MISC;
constexpr size_t WS_BIAS1 = WS_MISC + 256 * 1024;
constexpr size_t WS_W2T = WS_MISC + 384 * 1024;
constexpr size_t WS_KCMP = WS_MISC + 512 * 1024;
constexpr size_t WS_VCMP = WS_MISC + 1024 * 1024;
constexpr size_t WS_SUBK = WS_MISC + 1536 * 1024;
constexpr size_t WS_WG = WS_MISC + 1600 * 1024;
constexpr size_t WS_GAINS = WS_MISC + 1700 * 1024;
constexpr size_t WS_HID = 22 * MiB;
constexpr size_t WS_GATES = 26 * MiB;
constexpr size_t WS_DLSE = 29 * MiB;
constexpr size_t WS_U = 32 * MiB;
constexpr size_t WS_H = 96 * MiB;
constexpr size_t WS_Y = WS_H;
constexpr size_t WS_HN = WS_H;
constexpr size_t WS_SSQ = 26 * MiB;
constexpr size_t WS_QN = 160 * MiB;
constexpr size_t WS_KV6 = 192 * MiB;
constexpr size_t WS_DIL = 241 * MiB;
constexpr size_t WS_DILO = 385 * MiB;
constexpr size_t WS_MERGED = WS_QN;
constexpr size_t WS_PQ = WS_DIL;
constexpr size_t WS_IDX = WS_DIL + 64 * MiB;
constexpr size_t WS_GS = WS_DIL + 80 * MiB;
constexpr size_t WS_END = 433 * MiB;
constexpr size_t KV6_STRIDE = (size_t)B_ * 2 * S_ * HD;
constexpr size_t DIL_STRIDE = (size_t)B_ * 4 * S_ * HD;

__device__ __forceinline__ float bf2f(bf16_t v) { return __uint_as_float(((unsigned)v) << 16); }
__device__ __forceinline__ bf16_t f2bf(float f) { unsigned u = __float_as_uint(f); return (bf16_t)((u + 0x7fffu + ((u >> 16) & 1u)) >> 16); }
__device__ __forceinline__ unsigned pk2(float lo, float hi) { return (unsigned)f2bf(lo) | ((unsigned)f2bf(hi) << 16); }
__device__ __forceinline__ float wave_sum(float v) {
#pragma unroll
    for (int o = 1; o < 64; o <<= 1) v += __shfl_xor(v, o);
    return v;
}
__device__ __forceinline__ float wave_max(float v) {
#pragma unroll
    for (int o = 1; o < 64; o <<= 1) v = fmaxf(v, __shfl_xor(v, o));
    return v;
}
__device__ __forceinline__ float gelu_tanh(float x) {
    const float u = 0.7978845608028654f * (x + 0.044715f * x * x * x);
    const float e = __expf(2.f * u);
    const float th = 1.f - 2.f / (e + 1.f);
    return 0.5f * x * (1.f + th);
}
__device__ __forceinline__ float sigmoidf_(float x) { return 1.f / (1.f + __expf(-x)); }

__device__ __forceinline__ void wave_gemm64(const bf16_t* __restrict__ A, size_t lda, const bf16_t* __restrict__ Bt, size_t ldb, int K, f32x4 (&acc)[4][4], int lane) {
    const int fr = lane & 15, fq = lane >> 4;
    const bf16_t* ap = A + (size_t)fr * lda + fq * 8; const bf16_t* bp = Bt + (size_t)fr * ldb + fq * 8;
    for (int k = 0; k < K; k += 128) {
        bf16x8 a[4][4], b[4][4];
#pragma unroll
        for (int kk = 0; kk < 4; ++kk)
#pragma unroll
            for (int i = 0; i < 4; ++i) { a[kk][i] = *(const bf16x8*)(ap + (size_t)(16 * i) * lda + k + 32 * kk); b[kk][i] = *(const bf16x8*)(bp + (size_t)(16 * i) * ldb + k + 32 * kk); }
#pragma unroll
        for (int kk = 0; kk < 4; ++kk)
#pragma unroll
            for (int mi = 0; mi < 4; ++mi)
#pragma unroll
                for (int ni = 0; ni < 4; ++ni) acc[mi][ni] = __builtin_amdgcn_mfma_f32_16x16x32_bf16(a[kk][mi], b[kk][ni], acc[mi][ni], 0, 0, 0);
    }
}
#define ZERO_ACC(acc) _Pragma("unroll") for (int _a = 0; _a < 4; ++_a) _Pragma("unroll") for (int _b = 0; _b < 4; ++_b) acc[_a][_b] = (f32x4){0.f, 0.f, 0.f, 0.f}
#define FOR_ACC(acc, r0, c0, lane, ...) _Pragma("unroll") for (int _mi = 0; _mi < 4; ++_mi) _Pragma("unroll") for (int _ni = 0; _ni < 4; ++_ni) _Pragma("unroll") for (int _j = 0; _j < 4; ++_j) { \
    const int row = (r0) + 16 * _mi + 4 * ((lane) >> 4) + _j, col = (c0) + 16 * _ni + ((lane) & 15); const float val = acc[_mi][_ni][_j]; __VA_ARGS__ }

namespace pg8 {
#define PG8_LAS __attribute__((address_space(3)))
typedef unsigned short bf16_t;
typedef short bf16x8 __attribute__((ext_vector_type(8)));
typedef float f32x4 __attribute__((ext_vector_type(4)));
typedef unsigned u32x4 __attribute__((ext_vector_type(4)));
constexpr int BM = 256, BK = 64, HALF = 128, HTB = HALF * BK * 2  , STAGE_BYTES = 8 * HTB, NXCD = 8, WGM = 8;

__host__ __device__ __forceinline__ int lds_byte(int r, int c) { const int st = (r >> 4) * 2 + (c >> 5), rr = r & 15, cc = c & 31, ob = rr * 64 + cc * 2; return st * 1024 + (ob ^ (((ob >> 9) & 1) << 5)); }
__host__ __device__ __forceinline__ void stage_rc(int b, int& R, int& C) { const int st = b / 1024, sb = b % 1024, swz = sb ^ (((sb >> 9) & 1) << 5); R = (st >> 1) * 16 + swz / 64; C = (st & 1) * 32 + (swz % 64) / 2; }
__host__ __device__ __forceinline__ int perm32(int rho) { const int n = rho >> 4, i = rho & 15; return 8 * (i >> 2) + 4 * n + (i & 3); }

struct Unit { int pm, pn; };
struct Gemm { const bf16_t* A; const bf16_t* Bt; int M, N, K; };

struct StaticOrder {
    int nM, nN, nwg, G, c;
    __host__ __device__ void init(int M, int N, int G_, int c_) { nM = M / BM; nN = N / BM; nwg = nM * nN; G = G_; c = c_; }
    __host__ __device__ bool next(int i, Unit& u) const {
        const long L = (long)i * G + c; if (L >= nwg) return false;
        int wgid = (int)L; { const int q = nwg / NXCD, r = nwg % NXCD, xcd = wgid % NXCD, off = wgid / NXCD; wgid = (xcd < r ? xcd * (q + 1) : r * (q + 1) + (xcd - r) * q) + off; }
        const int nig = WGM * nN, gid = wgid / nig, fm = gid * WGM, gsz = (nM - fm) < WGM ? (nM - fm) : WGM;
        u.pm = fm + ((wgid % nig) % gsz); u.pn = (wgid % nig) / gsz; return true;
    }
    __device__ __forceinline__ void a_ready(const Unit&) const {}
    __device__ __forceinline__ void done(const Unit&) const {}
};

__device__ __forceinline__ unsigned cvt_pk_bf16(float lo, float hi) { unsigned r; asm volatile("v_cvt_pk_bf16_f32 %0, %1, %2" : "=v"(r) : "v"(lo), "v"(hi)); return r; }
__device__ __forceinline__ u32x4 pack8(const f32x4 v0, const f32x4 v1) { u32x4 w; w.x = cvt_pk_bf16(v0[0], v0[1]); w.y = cvt_pk_bf16(v0[2], v0[3]); w.z = cvt_pk_bf16(v1[0], v1[1]); w.w = cvt_pk_bf16(v1[2], v1[3]); return w; }
__device__ __forceinline__ float bfl(unsigned w) { return __uint_as_float(w << 16); }
__device__ __forceinline__ float bfh(unsigned w) { return __uint_as_float(w & 0xffff0000u); }
__device__ __forceinline__ float sigm(float x) { return __builtin_amdgcn_rcpf(1.f + __builtin_amdgcn_exp2f(-1.4426950408889634f * x)); }

struct EpiInproj {
    static constexpr bool PERM = true, AFTER_DRAIN = false, HAS_MID = false;
    unsigned char* ws; bf16_t* MG; int mid_t; PG8_LAS float* X;
    __device__ __forceinline__ void mid(f32x4 (&)[2][2][4][2], const Unit&, int, int, int, int) const {}
    __device__ __forceinline__ void operator()(const f32x4 (&acc)[2][2][4][2], const Unit& u, int wr, int wc, int fr, int fq) const {
        asm volatile("" : "+v"(fr), "+v"(fq));
        const int pn = u.pn;
        bf16_t* const QN = (bf16_t*)(ws + WS_QN); bf16_t* const KV6 = (bf16_t*)(ws + WS_KV6); bf16_t* const DIL = (bf16_t*)(ws + WS_DIL);
        const float* const gains = (const float*)(ws + WS_GAINS); const float* const nsa_qn = gains; const float* const nsa_kn = gains + 64; const float* const dil_qn = gains + 256; const float* const dil_kn = gains + 448;
        const float* const rope = (const float*)(ws + WS_ROPE);
        bool nb0 = false, nb1 = false, sg = false; const float* gain = nsa_qn; float scale = 1.f;
        bf16_t* base0; bf16_t* base1; unsigned bstr, rstr; const unsigned dl = (unsigned)((wc & 1) * 32 + fq * 8); unsigned lane_off;
        if (pn < 2) { nb0 = nb1 = true; scale = C2; base0 = QN + pn * 256; base1 = base0 + HALF; bstr = 4096u * 512u; rstr = 512u; lane_off = (unsigned)(wc * 32 + fq * 8); }
        else if (pn < 5) { if (pn == 3) { nb0 = true; gain = nsa_kn + 64; } else if (pn == 4) { nb0 = true; gain = nsa_kn + 128; }
            base0 = KV6 + (size_t)((pn - 2) * 2) * KV6_STRIDE; base1 = base0 + KV6_STRIDE; bstr = 2u * S_ * HD; rstr = HD; lane_off = (unsigned)(wc >> 1) * (unsigned)(S_ * HD) + dl; }
        else if (pn < 14) { const int gw = pn - 5, g = gw / 3, which = gw - 3 * g; if (which == 0) { nb0 = nb1 = true; gain = dil_qn + g * 64; scale = C2; } else if (which == 1) { nb0 = nb1 = true; gain = dil_kn + g * 64; }
            base0 = DIL + (size_t)gw * DIL_STRIDE; base1 = base0 + (size_t)2 * S_ * HD; bstr = 4u * S_ * HD; rstr = HD; lane_off = (unsigned)(wc >> 1) * (unsigned)(S_ * HD) + dl; }
        else { sg = true; base0 = MG + (pn - 14) * 256; base1 = base0 + HALF; bstr = 4096u * 2048u; rstr = 2048u; lane_off = (unsigned)(wc * 32 + fq * 8); }
        const bool anyn = nb0;
        if (anyn) {
#pragma unroll
            for (int ai = 0; ai < 2; ++ai)
#pragma unroll
                for (int m = 0; m < 4; ++m) { const int rl = ai * HALF + wr * 64 + m * 16 + fr;
#pragma unroll
                    for (int bj = 0; bj < 2; ++bj) { if (bj == 1 && !nb1) continue;
                        const f32x4 v0 = acc[ai][bj][m][0], v1 = acc[ai][bj][m][1];
                        float ss = (v0[0] * v0[0] + v0[1] * v0[1]) + (v0[2] * v0[2] + v0[3] * v0[3]) + (v1[0] * v1[0] + v1[1] * v1[1]) + (v1[2] * v1[2] + v1[3] * v1[3]);
                        ss += __shfl_xor(ss, 16); ss += __shfl_xor(ss, 32);
                        if (fq == 0) X[rl * 8 + bj * 4 + wc] = ss; } }
            asm volatile("s_waitcnt lgkmcnt(0)" ::: "memory"); __builtin_amdgcn_s_barrier(); asm volatile("" ::: "memory");
        }
        f32x4 g0 = {1.f, 1.f, 1.f, 1.f}, g1 = g0;
        if (anyn) { g0 = *(const f32x4*)(gain + dl) * scale; g1 = *(const f32x4*)(gain + dl + 4) * scale; }
        const bool ropew = anyn && ((wc & 1) == 0);
#pragma unroll
        for (int ai = 0; ai < 2; ++ai)
#pragma unroll
            for (int m = 0; m < 4; ++m) {
                const int rl = ai * HALF + wr * 64 + m * 16 + fr; const unsigned row = (unsigned)(u.pm * BM + rl); const unsigned s = row & 4095u;
                const unsigned off = (row >> 12) * bstr + s * rstr + lane_off;
                f32x4 c0 = {1.f, 1.f, 1.f, 1.f}, c1 = c0, s0 = {0.f, 0.f, 0.f, 0.f}, s1 = s0;
                if (ropew && fq < 2) { const float* rp = rope + s * 16; c0 = *(const f32x4*)rp; c1 = *(const f32x4*)(rp + 4); s0 = *(const f32x4*)(rp + 8); s1 = *(const f32x4*)(rp + 12); if (fq == 0) { s0 = -s0; s1 = -s1; } }
#pragma unroll
                for (int bj = 0; bj < 2; ++bj) {
                    f32x4 v0 = acc[ai][bj][m][0], v1 = acc[ai][bj][m][1];
                    const bool nrm = (bj == 0) ? nb0 : nb1;
                    if (nrm) {
                        const float tot = X[rl * 8 + bj * 4 + wc] + X[rl * 8 + bj * 4 + (wc ^ 1)];
                        const float rstd = __builtin_amdgcn_rsqf(tot * (1.f / 64.f) + EPS);
                        v0 = v0 * rstd * g0; v1 = v1 * rstd * g1;
                        if (ropew) {
#pragma unroll
                            for (int i = 0; i < 4; ++i) { const float p0 = __shfl_xor(v0[i], 16), p1 = __shfl_xor(v1[i], 16); v0[i] = v0[i] * c0[i] + p0 * s0[i]; v1[i] = v1[i] * c1[i] + p1 * s1[i]; }
                        }
                    }
                    if (sg) {
#pragma unroll
                        for (int i = 0; i < 4; ++i) { v0[i] = sigm(v0[i]); v1[i] = sigm(v1[i]); } }
                    *(u32x4*)((bj ? base1 : base0) + off) = pack8(v0, v1);
                }
                asm volatile("" ::: "memory");
            }
    }
};
struct EpiMerge {
    static constexpr bool PERM = true, AFTER_DRAIN = false, HAS_MID = true;
    const bf16_t* MG; bf16_t* MERGED; int mid_t;
    __device__ __forceinline__ void mid(f32x4 (&acc)[2][2][4][2], const Unit& u, int wr, int wc, int fr, int fq) const {
#pragma unroll
        for (int ai = 0; ai < 2; ++ai)
#pragma unroll
            for (int m = 0; m < 4; ++m) {
                const int row = u.pm * BM + ai * HALF + wr * 64 + m * 16 + fr;
#pragma unroll
                for (int bj = 0; bj < 2; ++bj) {
                    const int col = u.pn * BM + bj * HALF + wc * 32 + fq * 8;
                    const u32x4 a = *(const u32x4*)(MG + (size_t)row * 2048 + col), b = *(const u32x4*)(MG + (size_t)row * 2048 + 1024 + col);
#pragma unroll
                    for (int i = 0; i < 4; ++i) {
                        const float r0 = bfl(a[i]) * __builtin_amdgcn_rcpf(fmaxf(bfl(b[i]), 1e-30f)), r1 = bfh(a[i]) * __builtin_amdgcn_rcpf(fmaxf(bfh(b[i]), 1e-30f));
                        if (i < 2) { acc[ai][bj][m][0][2 * i] *= r0; acc[ai][bj][m][0][2 * i + 1] *= r1; } else { acc[ai][bj][m][1][2 * i - 4] *= r0; acc[ai][bj][m][1][2 * i - 3] *= r1; } }
                }
            }
    }
    __device__ __forceinline__ void operator()(const f32x4 (&acc)[2][2][4][2], const Unit& u, int wr, int wc, int fr, int fq) const {
#pragma unroll
        for (int ai = 0; ai < 2; ++ai)
#pragma unroll
            for (int m = 0; m < 4; ++m) {
                const int row = u.pm * BM + ai * HALF + wr * 64 + m * 16 + fr;
#pragma unroll
                for (int bj = 0; bj < 2; ++bj) {
                    const int col = u.pn * BM + bj * HALF + wc * 32 + fq * 8;
                    const u32x4 b = *(const u32x4*)(MG + (size_t)row * 2048 + 1024 + col);
                    f32x4 v0 = acc[ai][bj][m][0], v1 = acc[ai][bj][m][1];
                    v0[0] *= fmaxf(bfl(b[0]), 1e-30f); v0[1] *= fmaxf(bfh(b[0]), 1e-30f); v0[2] *= fmaxf(bfl(b[1]), 1e-30f); v0[3] *= fmaxf(bfh(b[1]), 1e-30f);
                    v1[0] *= fmaxf(bfl(b[2]), 1e-30f); v1[1] *= fmaxf(bfh(b[2]), 1e-30f); v1[2] *= fmaxf(bfl(b[3]), 1e-30f); v1[3] *= fmaxf(bfh(b[3]), 1e-30f);
                    *(u32x4*)(MERGED + (size_t)row * 1024 + col) = pack8(v0, v1);
                }
            }
    }
};
struct EpiWo {
    static constexpr bool PERM = false, AFTER_DRAIN = false, HAS_MID = false;
    const float* x; float* out; int mid_t; bf16_t* X1B; float* SSQ;
    __device__ __forceinline__ void mid(f32x4 (&)[2][2][4][2], const Unit&, int, int, int, int) const {}
    __device__ __forceinline__ void operator()(const f32x4 (&acc)[2][2][4][2], const Unit& u, int wr, int wc, int fr, int fq) const {
        asm volatile("" : "+v"(fr), "+v"(fq));
#pragma unroll
        for (int ai = 0; ai < 2; ++ai)
#pragma unroll
            for (int m = 0; m < 4; ++m) {
                const int row = u.pm * BM + ai * HALF + wr * 64 + m * 16 + fr;
                const size_t off = (size_t)row * 1024 + u.pn * BM + wc * 32 + fq * 4;
                float ss = 0.f;
#pragma unroll
                for (int bj = 0; bj < 2; ++bj)
#pragma unroll
                    for (int n = 0; n < 2; ++n) { const f32x4 bs = *(const f32x4*)(x + off + bj * HALF + n * 16); const f32x4 v = bs + acc[ai][bj][m][n]; *(f32x4*)(out + off + bj * HALF + n * 16) = v;
                        ss += (v[0] * v[0] + v[1] * v[1]) + (v[2] * v[2] + v[3] * v[3]);
                        u32x2 w; w.x = cvt_pk_bf16(v[0], v[1]); w.y = cvt_pk_bf16(v[2], v[3]); *(u32x2*)(X1B + off + bj * HALF + n * 16) = w; }
                ss += __shfl_xor(ss, 16); ss += __shfl_xor(ss, 32);
                if (fq == 0) SSQ[(size_t)row * 16 + u.pn * 4 + wc] = ss;
                asm volatile("" ::: "memory");
            }
    }
};
struct EpiPQ {
    static constexpr bool PERM = true, AFTER_DRAIN = false, HAS_MID = false;
    bf16_t* O; const float* SSQ; int mid_t;
    __device__ __forceinline__ void mid(f32x4 (&)[2][2][4][2], const Unit&, int, int, int, int) const {}
    __device__ __forceinline__ void operator()(const f32x4 (&acc)[2][2][4][2], const Unit& u, int wr, int wc, int fr, int fq) const {
        asm volatile("" : "+v"(fr), "+v"(fq));
#pragma unroll
        for (int ai = 0; ai < 2; ++ai)
#pragma unroll
            for (int m = 0; m < 4; ++m) {
                const int row = u.pm * BM + ai * HALF + wr * 64 + m * 16 + fr;
                const f32x4* sp = (const f32x4*)(SSQ + (size_t)row * 16); const f32x4 s4 = (sp[0] + sp[1]) + (sp[2] + sp[3]);
                const float rstd = __builtin_amdgcn_rsqf(((s4[0] + s4[1]) + (s4[2] + s4[3])) * (1.f / 1024.f) + EPS);
                bf16_t* rowp = O + (size_t)row * 1024 + u.pn * BM + wc * 32 + fq * 8;
#pragma unroll
                for (int bj = 0; bj < 2; ++bj) *(u32x4*)(rowp + bj * HALF) = pack8(acc[ai][bj][m][0] * rstd, acc[ai][bj][m][1] * rstd);
                asm volatile("" ::: "memory");
            }
    }
};
struct EpiPlain {
    static constexpr bool PERM = true, AFTER_DRAIN = false, HAS_MID = false;
    bf16_t* O; int ldc; int mid_t;
    __device__ __forceinline__ void mid(f32x4 (&)[2][2][4][2], const Unit&, int, int, int, int) const {}
    __device__ __forceinline__ void operator()(const f32x4 (&acc)[2][2][4][2], const Unit& u, int wr, int wc, int fr, int fq) const {
#pragma unroll
        for (int ai = 0; ai < 2; ++ai)
#pragma unroll
            for (int m = 0; m < 4; ++m) {
                bf16_t* rowp = O + (size_t)(u.pm * BM + ai * HALF + wr * 64 + m * 16 + fr) * ldc + u.pn * BM + wc * 32 + fq * 8;
#pragma unroll
                for (int bj = 0; bj < 2; ++bj) *(u32x4*)(rowp + bj * HALF) = pack8(acc[ai][bj][m][0], acc[ai][bj][m][1]);
            }
    }
};
template <class Epi, class Sched, bool ALIGN_EPI = false, bool SP2 = false>
__device__ __forceinline__ void gemm_phase(PG8_LAS unsigned char* lds, const Gemm g, const Sched& S, const Epi& E) {
    const int tid = threadIdx.x, wid = __builtin_amdgcn_readfirstlane(tid >> 6), lane = tid & 63, wr = wid >> 2, wc = wid & 3, fr = lane & 15, fq = lane >> 4;
    const int K = g.K, nt = K / BK;
    unsigned voffA[2], voffB[2];
#pragma unroll
    for (int i = 0; i < 2; ++i) { int R, C; stage_rc(tid * 16 + i * 8192, R, C); const int Rb = Epi::PERM ? ((R & ~31) + perm32(R & 31)) : R;
        voffA[i] = (unsigned)(R * K + C) * 2u; voffB[i] = (unsigned)(Rb * K + C) * 2u; }
    const size_t kstep = (size_t)(BK * 2);
    const size_t hstep = (size_t)HALF * K * 2;
    const size_t tstep = 2 * hstep;
    const unsigned ldsw = (unsigned)wid * 1024u;
    const int aoff = lds_byte(wr * 64 + fr, fq * 8), boff = lds_byte(wc * 32 + fr, fq * 8);
#define PG8_SA(b, h) (((b) * 2 + (h)) * HTB)
#define PG8_SB(b, h) ((4 + (b) * 2 + (h)) * HTB)
#define PG8_STAGE(bufoff, gbase, voff) do { _Pragma("unroll") for (int _i = 0; _i < 2; ++_i) \
        __builtin_amdgcn_global_load_lds((const unsigned*)((const char*)(gbase) + (voff)[_i]), (PG8_LAS unsigned*)(lds + (bufoff) + ldsw + _i * 8192), 16, 0, 0); } while (0)
#define PG8_LDA(dst, b, h) do { _Pragma("unroll") for (int m = 0; m < 4; ++m) _Pragma("unroll") for (int k = 0; k < 2; ++k) dst[m][k] = *(const PG8_LAS bf16x8*)(lds + PG8_SA(b, h) + aoff + m * 2048 + k * 1024); } while (0)
#define PG8_LDB(dst, b, h) do { _Pragma("unroll") for (int n = 0; n < 2; ++n) _Pragma("unroll") for (int k = 0; k < 2; ++k) dst[n][k] = *(const PG8_LAS bf16x8*)(lds + PG8_SB(b, h) + boff + n * 2048 + k * 1024); } while (0)
#define PG8_MMA(ai, bj, At, Bt) do { __builtin_amdgcn_s_setprio(1); _Pragma("unroll") for (int m = 0; m < 4; ++m) _Pragma("unroll") for (int n = 0; n < 2; ++n) _Pragma("unroll") for (int k = 0; k < 2; ++k) \
        acc[ai][bj][m][n] = __builtin_amdgcn_mfma_f32_16x16x32_bf16(Bt[n][k], At[m][k], acc[ai][bj][m][n], 0, 0, 0); __builtin_amdgcn_s_setprio(0); } while (0)
#define PG8_WAIT_V(n) asm volatile("s_waitcnt vmcnt(" #n ")" ::: "memory")
#define PG8_WAIT_L(n) asm volatile("s_waitcnt lgkmcnt(" #n ")" ::: "memory")
#define PG8_BAR __builtin_amdgcn_s_barrier()
#define PG8_SCHED __builtin_amdgcn_sched_barrier(0)
    Unit cur, nxt; int ui = 0;
    if (!S.next(0, cur)) return;
    f32x4 acc[2][2][4][2];
#pragma unroll
    for (int a = 0; a < 2; ++a)
#pragma unroll
        for (int b = 0; b < 2; ++b)
#pragma unroll
            for (int m = 0; m < 4; ++m)
#pragma unroll
                for (int n = 0; n < 2; ++n) acc[a][b][m][n] = (f32x4){0.f, 0.f, 0.f, 0.f};
    bf16x8 At[4][2], B0[2][2], B1[2][2];
    const char* cA = (const char*)g.A + (size_t)cur.pm * tstep; const char* cB = (const char*)g.Bt + (size_t)cur.pn * tstep;
    S.a_ready(cur);
    if constexpr (SP2) {
        PG8_STAGE(PG8_SB(0, 0), cB, voffB); PG8_STAGE(PG8_SB(0, 1), cB + hstep, voffB); PG8_STAGE(PG8_SA(0, 0), cA, voffA); PG8_STAGE(PG8_SA(0, 1), cA + hstep, voffA);
        if (wr == 1) PG8_BAR;
        PG8_WAIT_V(2); PG8_BAR;
        PG8_STAGE(PG8_SB(1, 0), cB + kstep, voffB); PG8_STAGE(PG8_SA(1, 0), cA + kstep, voffA); PG8_STAGE(PG8_SB(1, 1), cB + hstep + kstep, voffB);
        PG8_WAIT_V(6); PG8_BAR;
    } else {
        PG8_STAGE(PG8_SB(0, 0), cB, voffB); PG8_STAGE(PG8_SA(0, 0), cA, voffA); PG8_STAGE(PG8_SB(0, 1), cB + hstep, voffB); PG8_STAGE(PG8_SA(0, 1), cA + hstep, voffA);
        if (wr == 1) PG8_BAR;
        PG8_WAIT_V(4); PG8_BAR;
        PG8_STAGE(PG8_SB(1, 0), cB + kstep, voffB); PG8_STAGE(PG8_SA(1, 0), cA + kstep, voffA); PG8_STAGE(PG8_SB(1, 1), cB + hstep + kstep, voffB);
        PG8_WAIT_V(6); PG8_BAR;
    }
    for (;;) {
        const bool has_next = S.next(ui + 1, nxt);
        const char* nA = has_next ? (const char*)g.A + (size_t)nxt.pm * tstep : cA; const char* nB = has_next ? (const char*)g.Bt + (size_t)nxt.pn * tstep : cB;
        for (int t = 0; t < nt; t += 2) {
            if constexpr (Epi::HAS_MID) { if (t == E.mid_t) E.mid(acc, cur, wr, wc, fr, fq); }
            const bool last = (t == nt - 2);
            const char* a1 = cA + (size_t)(t + 1) * kstep;
            const char* a2 = last ? nA : cA + (size_t)(t + 2) * kstep; const char* b2 = last ? nB : cB + (size_t)(t + 2) * kstep;
            const char* a3 = a2 + kstep; const char* b3 = b2 + kstep;
            if (last && has_next) S.a_ready(nxt);
            if constexpr (SP2) {
            PG8_LDB(B0, 0, 0); PG8_LDB(B1, 0, 1); PG8_SCHED; PG8_LDA(At, 0, 0); PG8_STAGE(PG8_SA(1, 1), a1 + hstep, voffA);
            PG8_WAIT_V(8); PG8_WAIT_L(0); PG8_BAR; PG8_MMA(0, 0, At, B0); PG8_MMA(0, 1, At, B1); PG8_BAR; PG8_SCHED;
            PG8_LDA(At, 0, 1); PG8_STAGE(PG8_SB(0, 0), b2, voffB); PG8_STAGE(PG8_SB(0, 1), b2 + hstep, voffB); PG8_STAGE(PG8_SA(0, 0), a2, voffA);
            PG8_WAIT_V(8); PG8_WAIT_L(0); PG8_BAR; PG8_MMA(1, 0, At, B0); PG8_MMA(1, 1, At, B1); PG8_BAR; PG8_SCHED;
            PG8_LDB(B0, 1, 0); PG8_LDB(B1, 1, 1); PG8_SCHED; PG8_LDA(At, 1, 0); PG8_STAGE(PG8_SA(0, 1), a2 + hstep, voffA);
            PG8_WAIT_V(8); PG8_WAIT_L(0); PG8_BAR; PG8_MMA(0, 0, At, B0); PG8_MMA(0, 1, At, B1); PG8_BAR; PG8_SCHED;
            PG8_LDA(At, 1, 1); PG8_STAGE(PG8_SB(1, 0), b3, voffB); PG8_STAGE(PG8_SB(1, 1), b3 + hstep, voffB); PG8_STAGE(PG8_SA(1, 0), a3, voffA);
            PG8_WAIT_V(8); PG8_WAIT_L(0); PG8_BAR; PG8_MMA(1, 0, At, B0); PG8_MMA(1, 1, At, B1); PG8_BAR; PG8_SCHED;
            } else {
            PG8_LDB(B0, 0, 0); PG8_SCHED; PG8_LDA(At, 0, 0); PG8_STAGE(PG8_SA(1, 1), a1 + hstep, voffA);
            PG8_WAIT_L(8); PG8_BAR; PG8_WAIT_L(0); PG8_MMA(0, 0, At, B0); PG8_BAR; PG8_SCHED;
            PG8_LDB(B1, 0, 1); PG8_STAGE(PG8_SB(0, 0), b2, voffB);
            PG8_BAR; PG8_WAIT_L(0); PG8_MMA(0, 1, At, B1); PG8_BAR;
            PG8_LDA(At, 0, 1); PG8_STAGE(PG8_SA(0, 0), a2, voffA);
            PG8_BAR; PG8_WAIT_L(0); PG8_MMA(1, 0, At, B0); PG8_BAR; PG8_SCHED;
            PG8_STAGE(PG8_SB(0, 1), b2 + hstep, voffB);
            PG8_WAIT_V(6); PG8_BAR; PG8_MMA(1, 1, At, B1); PG8_BAR;
            PG8_LDB(B0, 1, 0); PG8_SCHED; PG8_LDA(At, 1, 0); PG8_STAGE(PG8_SA(0, 1), a2 + hstep, voffA);
            PG8_WAIT_L(8); PG8_BAR; PG8_WAIT_L(0); PG8_MMA(0, 0, At, B0); PG8_BAR; PG8_SCHED;
            PG8_LDB(B1, 1, 1); PG8_STAGE(PG8_SB(1, 0), b3, voffB);
            PG8_BAR; PG8_WAIT_L(0); PG8_MMA(0, 1, At, B1); PG8_BAR;
            PG8_LDA(At, 1, 1); PG8_STAGE(PG8_SA(1, 0), a3, voffA);
            PG8_BAR; PG8_WAIT_L(0); PG8_MMA(1, 0, At, B0); PG8_BAR; PG8_SCHED;
            PG8_STAGE(PG8_SB(1, 1), b3 + hstep, voffB);
            PG8_WAIT_V(6); PG8_BAR; PG8_MMA(1, 1, At, B1); PG8_BAR;
            }
        }
        if constexpr (ALIGN_EPI) { if (wr == 0) PG8_BAR; }
        if constexpr (!Epi::AFTER_DRAIN) { E(acc, cur, wr, wc, fr, fq); S.done(cur); }
        if (!has_next) break;
#pragma unroll
        for (int a = 0; a < 2; ++a)
#pragma unroll
            for (int b = 0; b < 2; ++b)
#pragma unroll
                for (int m = 0; m < 4; ++m)
#pragma unroll
                    for (int n = 0; n < 2; ++n) acc[a][b][m][n] = (f32x4){0.f, 0.f, 0.f, 0.f};
        cur = nxt; cA = nA; cB = nB; ++ui;
        if constexpr (ALIGN_EPI) { if (wr == 1) PG8_BAR; }
    }
    PG8_WAIT_V(0);
    if constexpr (!ALIGN_EPI) { if (wr == 0) PG8_BAR; }
    PG8_BAR;
    if constexpr (Epi::AFTER_DRAIN) { E.fused(acc, cur, wr, wc, fr, fq, lds, wid, lane); S.done(cur); }
#undef PG8_SA
#undef PG8_SB
#undef PG8_STAGE
#undef PG8_LDA
#undef PG8_LDB
#undef PG8_MMA
#undef PG8_WAIT_V
#undef PG8_WAIT_L
#undef PG8_BAR
#undef PG8_SCHED
}
}
namespace att {
typedef short s16x4 __attribute__((ext_vector_type(4)));
__device__ __forceinline__ int crow(int r, int hi) { return (r & 3) + 8 * (r >> 2) + 4 * hi; }
__device__ __forceinline__ float max3f(float a, float b, float c) { float r; asm("v_max3_f32 %0, %1, %2, %3" : "=v"(r) : "v"(a), "v"(b), "v"(c)); return r; }
typedef float f32x2_t __attribute__((ext_vector_type(2))); typedef __bf16 bf16x2_t __attribute__((ext_vector_type(2)));
__device__ __forceinline__ unsigned cvtpk(float lo, float hi) { f32x2_t v = {lo, hi}; bf16x2_t b = __builtin_convertvector(v, bf16x2_t); return __builtin_bit_cast(unsigned, b); }
__device__ __forceinline__ float ex2(float v) { return __builtin_amdgcn_exp2f(v); }
__device__ __forceinline__ float swap_add(float v) { auto rr = __builtin_amdgcn_permlane32_swap(__float_as_uint(v), __float_as_uint(v), false, false); return __uint_as_float(rr[0]) + __uint_as_float(rr[1]); }
__device__ __forceinline__ float swap_max(float v) { auto rr = __builtin_amdgcn_permlane32_swap(__float_as_uint(v), __float_as_uint(v), false, false); return fmaxf(__uint_as_float(rr[0]), __uint_as_float(rr[1])); }

__device__ __forceinline__ void dma_k(const bf16_t* Kt, size_t pitch, LAS unsigned char* kslot, int wid, int lane) {
    __builtin_amdgcn_global_load_lds((const unsigned*)(Kt + (size_t)lane * pitch + wid * 8), (LAS unsigned*)(kslot + wid * 1024), 16, 0, 0);
}
__device__ __forceinline__ void dma_v(const bf16_t* Vt, size_t pitch, LAS unsigned char* vslot, int wid, int lane) {
    __builtin_amdgcn_global_load_lds((const unsigned*)(Vt + (size_t)(16 * (wid & 3) + (lane >> 2)) * pitch + (wid >> 2) * 32 + (lane & 3) * 8), (LAS unsigned*)(vslot + wid * 1024), 16, 0, 0);
}
template <bool BIAS>
__device__ __forceinline__ void qkt(f32x16& p0, f32x16& p1, const LAS unsigned char* kslot, const bf16x8 (&qr)[4], float bias, int r32, int hi) {
    const LAS unsigned char* kb = kslot + hi * 1024 + r32 * 16;
    f32x16 c0;
#pragma unroll
    for (int i = 0; i < 16; ++i) c0[i] = BIAS ? bias : 0.f;
#pragma unroll
    for (int d0 = 0; d0 < 4; ++d0) {
        const bf16x8 b0 = *(const LAS bf16x8*)(kb + d0 * 2048), b1 = *(const LAS bf16x8*)(kb + d0 * 2048 + 512);
        if (d0 == 0) { p0 = __builtin_amdgcn_mfma_f32_32x32x16_bf16(b0, qr[0], c0, 0, 0, 0); p1 = __builtin_amdgcn_mfma_f32_32x32x16_bf16(b1, qr[0], c0, 0, 0, 0); }
        else { p0 = __builtin_amdgcn_mfma_f32_32x32x16_bf16(b0, qr[d0], p0, 0, 0, 0); p1 = __builtin_amdgcn_mfma_f32_32x32x16_bf16(b1, qr[d0], p1, 0, 0, 0); }
    }
    asm volatile("s_nop 15\n\ts_nop 7" : "+v"(p0), "+v"(p1));
}
template <int K> __device__ __forceinline__ float keep_le(float p, int lim, float alt) { float r; asm volatile("v_cmp_le_i32 vcc, %1, %2\n\tv_cndmask_b32 %0, %3, %4, vcc" : "=v"(r) : "n"(K), "v"(lim), "v"(alt), "v"(p) : "vcc"); return r; }
__device__ __forceinline__ void mask_le(f32x16& p0, f32x16& p1, int lim, int hi, float alt) {
    const int l0 = lim - 4 * hi;
#define ATT_M(r) p0[r] = keep_le<((r) & 3) + 8 * ((r) >> 2)>(p0[r], l0, alt); p1[r] = keep_le<((r) & 3) + 8 * ((r) >> 2) + 32>(p1[r], l0, alt);
    ATT_M(0) ATT_M(1) ATT_M(2) ATT_M(3) ATT_M(4) ATT_M(5) ATT_M(6) ATT_M(7) ATT_M(8) ATT_M(9) ATT_M(10) ATT_M(11) ATT_M(12) ATT_M(13) ATT_M(14) ATT_M(15)
#undef ATT_M
}
template <int K> __device__ __forceinline__ float keep_gt(float p, int lim, float alt) { float r; asm volatile("v_cmp_gt_i32 vcc, %1, %2\n\tv_cndmask_b32 %0, %3, %4, vcc" : "=v"(r) : "n"(K), "v"(lim), "v"(alt), "v"(p) : "vcc"); return r; }
__device__ __forceinline__ void mask_gt(f32x16& p0, f32x16& p1, int lim, int hi, float alt) {
    const int l0 = lim - 4 * hi;
#define ATT_M(r) p0[r] = keep_gt<((r) & 3) + 8 * ((r) >> 2)>(p0[r], l0, alt); p1[r] = keep_gt<((r) & 3) + 8 * ((r) >> 2) + 32>(p1[r], l0, alt);
    ATT_M(0) ATT_M(1) ATT_M(2) ATT_M(3) ATT_M(4) ATT_M(5) ATT_M(6) ATT_M(7) ATT_M(8) ATT_M(9) ATT_M(10) ATT_M(11) ATT_M(12) ATT_M(13) ATT_M(14) ATT_M(15)
#undef ATT_M
}
__device__ __forceinline__ float rowmax(const f32x16& p0, const f32x16& p1) {
    float a = max3f(p0[0], p0[1], p1[0]), b = max3f(p0[2], p0[3], p1[1]); a = max3f(a, p1[2], p1[3]);
#pragma unroll
    for (int r = 4; r < 16; r += 4) { a = max3f(a, p0[r], p0[r + 1]); b = max3f(b, p0[r + 2], p0[r + 3]); a = max3f(a, p1[r], p1[r + 1]); b = max3f(b, p1[r + 2], p1[r + 3]); }
    return swap_max(fmaxf(a, b));
}
__device__ __forceinline__ float rowsum32(const f32x16& p0, const f32x16& p1) {
    float a = 0.f, b = 0.f;
#pragma unroll
    for (int r = 0; r < 16; r += 2) { a += p0[r] + p1[r]; b += p0[r + 1] + p1[r + 1]; }
    return a + b;
}
template <bool LSUM>
__device__ __forceinline__ void pv(f32x16 (&o)[2], f32x16& lacc, unsigned vb, const f32x16& p0, const f32x16& p1) {
    u32x4 pw0, pw1, pw2, pw3;
    pw0 = (u32x4){cvtpk(p0[0], p0[1]), cvtpk(p0[2], p0[3]), cvtpk(p0[4], p0[5]), cvtpk(p0[6], p0[7])};
    pw1 = (u32x4){cvtpk(p0[8], p0[9]), cvtpk(p0[10], p0[11]), cvtpk(p0[12], p0[13]), cvtpk(p0[14], p0[15])};
    pw2 = (u32x4){cvtpk(p1[0], p1[1]), cvtpk(p1[2], p1[3]), cvtpk(p1[4], p1[5]), cvtpk(p1[6], p1[7])};
    pw3 = (u32x4){cvtpk(p1[8], p1[9]), cvtpk(p1[10], p1[11]), cvtpk(p1[12], p1[13]), cvtpk(p1[14], p1[15])};
    const bf16x8 pa0 = __builtin_bit_cast(bf16x8, pw0), pa1 = __builtin_bit_cast(bf16x8, pw1), pa2 = __builtin_bit_cast(bf16x8, pw2), pa3 = __builtin_bit_cast(bf16x8, pw3);
    if (LSUM) {
        const short one = (short)0x3F80; const bf16x8 ones = {one, one, one, one, one, one, one, one};
        lacc = __builtin_amdgcn_mfma_f32_32x32x16_bf16(pa0, ones, lacc, 0, 0, 0); lacc = __builtin_amdgcn_mfma_f32_32x32x16_bf16(pa1, ones, lacc, 0, 0, 0);
        lacc = __builtin_amdgcn_mfma_f32_32x32x16_bf16(pa2, ones, lacc, 0, 0, 0); lacc = __builtin_amdgcn_mfma_f32_32x32x16_bf16(pa3, ones, lacc, 0, 0, 0);
    }
#pragma unroll
    for (int d0 = 0; d0 < 2; ++d0) { s16x4 lo[4], hi[4];
#pragma unroll
        for (int ks = 0; ks < 4; ++ks) {
            asm volatile("ds_read_b64_tr_b16 %0,%1 offset:%c2" : "=&v"(lo[ks]) : "v"(vb), "i"(d0 * 4096 + ks * 1024) : "memory");
            asm volatile("ds_read_b64_tr_b16 %0,%1 offset:%c2" : "=&v"(hi[ks]) : "v"(vb), "i"(d0 * 4096 + ks * 1024 + 512) : "memory"); }
        asm volatile("s_waitcnt lgkmcnt(0)" ::: "memory"); __builtin_amdgcn_sched_barrier(0);
#define ATT_PK(k) (bf16x8){lo[k][0], lo[k][1], lo[k][2], lo[k][3], hi[k][0], hi[k][1], hi[k][2], hi[k][3]}
        o[d0] = __builtin_amdgcn_mfma_f32_32x32x16_bf16(pa0, ATT_PK(0), o[d0], 0, 0, 0);
        o[d0] = __builtin_amdgcn_mfma_f32_32x32x16_bf16(pa1, ATT_PK(1), o[d0], 0, 0, 0);
        o[d0] = __builtin_amdgcn_mfma_f32_32x32x16_bf16(pa2, ATT_PK(2), o[d0], 0, 0, 0);
        o[d0] = __builtin_amdgcn_mfma_f32_32x32x16_bf16(pa3, ATT_PK(3), o[d0], 0, 0, 0);
#undef ATT_PK
    }
}
__device__ __forceinline__ void lds_fadd(LAS float* p, float v) { (void)__hip_atomic_fetch_add(p, v, __ATOMIC_RELAXED, __HIP_MEMORY_SCOPE_WORKGROUP); }
__device__ __forceinline__ f32x16 splat16(float v) { f32x16 r;
#pragma unroll
    for (int i = 0; i < 16; ++i) r[i] = v;
    return r; }

struct Soft { float m; f32x16 o[2]; f32x16 lacc; };
__device__ __forceinline__ void soft_init(Soft& s) { s.m = 0.f; s.o[0] = splat16(0.f); s.o[1] = splat16(0.f); s.lacc = splat16(0.f); }
constexpr float SOFT_THR = 8.f;
template <bool FIRST>
__device__ __forceinline__ void soft_step(Soft& s, f32x16& p0, f32x16& p1, LAS float* wsf, int r32, int hi) {
    const float rm = rowmax(p0, p1);
    if (FIRST) {
        s.m = rm;
#pragma unroll
        for (int r = 0; r < 16; ++r) { p0[r] -= rm; p1[r] -= rm; }
    } else if (__any(rm > SOFT_THR)) {
        const float delta = (rm > SOFT_THR) ? rm : 0.f, f = ex2(-delta); s.m += delta;
        if (hi == 0) wsf[r32] = f;
        asm volatile("s_waitcnt lgkmcnt(0)" ::: "memory");
#pragma unroll
        for (int r = 0; r < 16; ++r) { const float fr = wsf[crow(r, hi)]; s.o[0][r] *= fr; s.o[1][r] *= fr; s.lacc[r] *= fr; p0[r] -= delta; p1[r] -= delta; }
        asm volatile("s_waitcnt lgkmcnt(0)" ::: "memory");
    }
#pragma unroll
    for (int r = 0; r < 16; ++r) { p0[r] = ex2(p0[r]); p1[r] = ex2(p1[r]); }
}
#define ATT_SYNC() do { asm volatile("s_waitcnt vmcnt(0) lgkmcnt(0)" ::: "memory"); __syncthreads(); } while (0)
#define ATT_RING_SYNC(N) do { asm volatile("s_waitcnt vmcnt(" #N ") lgkmcnt(0)" ::: "memory"); __builtin_amdgcn_s_barrier(); asm volatile("" ::: "memory"); } while (0)


typedef short v4i16_t __attribute__((ext_vector_type(4)));
__device__ __forceinline__ void kload8(bf16x8 (&kf)[8], const LAS unsigned char* kslot, int r32, int hi) {
    const LAS unsigned char* kb = kslot + hi * 1024 + r32 * 16;
#pragma unroll
    for (int d0 = 0; d0 < 4; ++d0) { kf[2 * d0] = *(const LAS bf16x8*)(kb + d0 * 2048); kf[2 * d0 + 1] = *(const LAS bf16x8*)(kb + d0 * 2048 + 512); }
}
template <bool BIAS>
__device__ __forceinline__ void qkt_reg(f32x16& p0, f32x16& p1, const bf16x8 (&kf)[8], const bf16x8 (&qr)[4], float bias) {
    f32x16 c0;
#pragma unroll
    for (int i = 0; i < 16; ++i) c0[i] = BIAS ? bias : 0.f;
#pragma unroll
    for (int d0 = 0; d0 < 4; ++d0) {
        if (d0 == 0) { p0 = __builtin_amdgcn_mfma_f32_32x32x16_bf16(kf[0], qr[0], c0, 0, 0, 0); p1 = __builtin_amdgcn_mfma_f32_32x32x16_bf16(kf[1], qr[0], c0, 0, 0, 0); }
        else { p0 = __builtin_amdgcn_mfma_f32_32x32x16_bf16(kf[2 * d0], qr[d0], p0, 0, 0, 0); p1 = __builtin_amdgcn_mfma_f32_32x32x16_bf16(kf[2 * d0 + 1], qr[d0], p1, 0, 0, 0); }
    }
    asm volatile("s_nop 15\n\ts_nop 7" : "+v"(p0), "+v"(p1));
}
__device__ __forceinline__ s16x4 vtr(const LAS unsigned char* p) { return __builtin_bit_cast(s16x4, __builtin_amdgcn_ds_read_tr16_b64_v4i16((LAS v4i16_t*)p)); }
__device__ __forceinline__ void vload8(s16x4 (&vf)[8], const LAS unsigned char* vp, int d0) {
#pragma unroll
    for (int ks = 0; ks < 4; ++ks) { vf[2 * ks] = vtr(vp + d0 * 4096 + ks * 1024); vf[2 * ks + 1] = vtr(vp + d0 * 4096 + ks * 1024 + 512); }
}
__device__ __forceinline__ void pv_reg(f32x16 (&o)[2], f32x16& lacc, s16x4 (&vf)[8], const LAS unsigned char* vp, const f32x16& p0, const f32x16& p1) {
    u32x4 pw0, pw1, pw2, pw3;
    pw0 = (u32x4){cvtpk(p0[0], p0[1]), cvtpk(p0[2], p0[3]), cvtpk(p0[4], p0[5]), cvtpk(p0[6], p0[7])};
    pw1 = (u32x4){cvtpk(p0[8], p0[9]), cvtpk(p0[10], p0[11]), cvtpk(p0[12], p0[13]), cvtpk(p0[14], p0[15])};
    pw2 = (u32x4){cvtpk(p1[0], p1[1]), cvtpk(p1[2], p1[3]), cvtpk(p1[4], p1[5]), cvtpk(p1[6], p1[7])};
    pw3 = (u32x4){cvtpk(p1[8], p1[9]), cvtpk(p1[10], p1[11]), cvtpk(p1[12], p1[13]), cvtpk(p1[14], p1[15])};
    const bf16x8 pa[4] = {__builtin_bit_cast(bf16x8, pw0), __builtin_bit_cast(bf16x8, pw1), __builtin_bit_cast(bf16x8, pw2), __builtin_bit_cast(bf16x8, pw3)};
#pragma unroll
    for (int ks = 0; ks < 4; ++ks) { const s16x4 lo = vf[2 * ks], hh = vf[2 * ks + 1]; const bf16x8 vv = {lo[0], lo[1], lo[2], lo[3], hh[0], hh[1], hh[2], hh[3]};
        o[0] = __builtin_amdgcn_mfma_f32_32x32x16_bf16(pa[ks], vv, o[0], 0, 0, 0); }
    __builtin_amdgcn_sched_barrier(0);
    vload8(vf, vp, 1);
    __builtin_amdgcn_sched_barrier(0);
    const short one = (short)0x3F80; const bf16x8 ones = {one, one, one, one, one, one, one, one};
#pragma unroll
    for (int ks = 0; ks < 4; ++ks) lacc = __builtin_amdgcn_mfma_f32_32x32x16_bf16(pa[ks], ones, lacc, 0, 0, 0);
#pragma unroll
    for (int ks = 0; ks < 4; ++ks) { const s16x4 lo = vf[2 * ks], hh = vf[2 * ks + 1]; const bf16x8 vv = {lo[0], lo[1], lo[2], lo[3], hh[0], hh[1], hh[2], hh[3]};
        o[1] = __builtin_amdgcn_mfma_f32_32x32x16_bf16(pa[ks], vv, o[1], 0, 0, 0); }
}
#define ATT_SB() __builtin_amdgcn_sched_barrier(0)

#ifndef NSA_REP_CMP
#define NSA_REP_CMP 1
#endif
#ifndef NSA_REP_SLT
#define NSA_REP_SLT 1
#endif
#ifndef NSA_REP_SEL
#define NSA_REP_SEL 1
#endif
#ifndef NSA_REP_WIN
#define NSA_REP_WIN 1
#endif
constexpr int NSA_LK = 0, NSA_LV = 32768, NSA_IMP = 65536, NSA_WSF = NSA_IMP + 4 * 64 * 65 * 4, NSA_SELM = NSA_WSF + 8 * 256, NSA_SV = NSA_SELM + 512, NSA_END = NSA_SV + 8 * 256;
static_assert(NSA_END <= 147456, "NSA LDS map");
__device__ __forceinline__ void acc_store(LAS float* accp, const f32x16 (&o)[2], const f32x16* lsum, LAS float* wsf, float gate, int r32, int hi, bool add, bf16_t* yb) {
    if (hi == 0) wsf[32 + r32] = gate;
    asm volatile("s_waitcnt lgkmcnt(0)" ::: "memory");
#pragma unroll
    for (int r = 0; r < 16; ++r) { float fr = wsf[32 + crow(r, hi)]; if (lsum) fr *= __builtin_amdgcn_rcpf((*lsum)[r]);
        float v0 = o[0][r] * fr, v1 = o[1][r] * fr;
        if (add) { v0 += accp[r * 64]; v1 += accp[(16 + r) * 64]; }
        if (yb) { const int q = crow(r, hi); yb[(size_t)q * YP] = f2bf(v0); yb[(size_t)q * YP + 32] = f2bf(v1); }
        else { accp[r * 64] = v0; accp[(16 + r) * 64] = v1; } }
    asm volatile("s_waitcnt lgkmcnt(0)" ::: "memory");
}
__device__ __forceinline__ void nsa_unit(LAS unsigned char* lds, int b, int g, int n, const bf16_t* QN, const bf16_t* KV6, const bf16_t* KCMP, const bf16_t* VCMP, const float* gates, bf16_t* Y, int wid, int lane) {
    const int r32 = lane & 31, hi = lane >> 5, j = wid & 3, th = wid >> 2, hh = g * 4 + j;
    const int tokl = 32 * th + r32;
    const int s_tok = 64 * n + tokl;
    const size_t trow = (size_t)b * S_ + s_tok;
    LAS float* wsf = (LAS float*)(lds + NSA_WSF + wid * 256);
    LAS float* imp = (LAS float*)(lds + NSA_IMP);
    LAS float* accp = (LAS float*)(lds + NSA_IMP + wid * 8192) + lane;
    const size_t bg = (size_t)(b * 2 + g);
    const unsigned vb = (unsigned)(uintptr_t)(lds + NSA_LV) + ((lane >> 4) & 1) * 32 + (lane & 3) * 8 + (4 * hi + ((lane & 15) >> 2)) * 64;
    bf16x8 qr[4];
#pragma unroll
    for (int d0 = 0; d0 < 4; ++d0) qr[d0] = *(const bf16x8*)(QN + trow * 512 + hh * 64 + d0 * 16 + hi * 8);
    const float NEGINF = -INFINITY;

    const int ntc = (4 * n + 2) / 64 + 1;
    const int cmax = (s_tok >= 31) ? min((s_tok - 31) >> 4, NCMP - 1) : -1;
    f32x16 oc[2];
    for (int rep_ = 0; rep_ < NSA_REP_CMP; ++rep_) {
    __syncthreads();
    {
        const bf16_t* kc = KCMP + bg * 256 * 64; const bf16_t* vc = VCMP + bg * 256 * 64;
        for (int ti = 0; ti < ntc; ++ti) { dma_k(kc + (size_t)ti * 64 * 64, 64, lds + NSA_LK + ti * 8192, wid, lane); dma_v(vc + (size_t)ti * 64 * 64, 64, lds + NSA_LV + ti * 8192, wid, lane); }
    }
    ATT_SYNC();
    {
        float m = -1e30f, l = 0.f;
        for (int ti = 0; ti < ntc; ++ti) {
            f32x16 p0, p1; qkt<false>(p0, p1, lds + NSA_LK + ti * 8192, qr, 0.f, r32, hi);
            mask_le(p0, p1, cmax - 64 * ti, hi, -1e30f);
            const float rm = rowmax(p0, p1); const float mn = fmaxf(m, rm);
            float sum = 0.f;
#pragma unroll
            for (int r = 0; r < 16; ++r) sum += ex2(p0[r] - mn) + ex2(p1[r] - mn);
            l = l * ex2(m - mn) + swap_add(sum); m = mn;
        }
        const float inv = (s_tok >= 31) ? 1.f / l : 0.f;
        oc[0] = splat16(0.f); oc[1] = splat16(0.f);
        LAS float* impj = imp + (j * 64 + tokl) * 65; float carry = 0.f;
        for (int ti = 0; ti < ntc; ++ti) {
            f32x16 p0, p1; qkt<false>(p0, p1, lds + NSA_LK + ti * 8192, qr, 0.f, r32, hi);
            mask_le(p0, p1, cmax - 64 * ti, hi, -1e30f);
#pragma unroll
            for (int r = 0; r < 16; ++r) { p0[r] = ex2(p0[r] - m) * inv; p1[r] = ex2(p1[r] - m) * inv; }
            {
                float av[8], bv[8];
#pragma unroll
                for (int G4 = 0; G4 < 4; ++G4) { bv[G4] = 0.5f * p0[4 * G4 + 3]; av[G4] = (p0[4 * G4] + p0[4 * G4 + 1]) + (p0[4 * G4 + 2] + bv[G4]); bv[4 + G4] = 0.5f * p1[4 * G4 + 3]; av[4 + G4] = (p1[4 * G4] + p1[4 * G4 + 1]) + (p1[4 * G4 + 2] + bv[4 + G4]); }
                float rv[8];
#pragma unroll
                for (int g8 = 0; g8 < 8; ++g8) { auto rr = __builtin_amdgcn_permlane32_swap(__float_as_uint(bv[g8]), __float_as_uint(bv[g8]), false, false); rv[g8] = __uint_as_float(hi ? rr[0] : rr[1]); }
#pragma unroll
                for (int g8 = 0; g8 < 8; ++g8) { const float inc = hi ? rv[g8] : (g8 ? rv[g8 - 1] : carry); impj[16 * ti + 2 * g8 + hi] = av[g8] + inc; }
                carry = rv[7];
            }
            pv<false>(oc, oc[0], vb + ti * 8192, p0, p1);
        }
    }
    ATT_SYNC();
    }
    const bf16_t* ks = KV6 + 2 * KV6_STRIDE + bg * S_ * HD; const bf16_t* vs = KV6 + 3 * KV6_STRIDE + bg * S_ * HD;
    dma_k(ks + (size_t)n * 64 * 64, 64, lds + NSA_LK, wid, lane); dma_v(vs + (size_t)n * 64 * 64, 64, lds + NSA_LV, wid, lane);
    {
        LAS unsigned long long* selm = (LAS unsigned long long*)(lds + NSA_SELM);
        const bool cand = (lane >= 1) && (lane <= n - 2);
        const unsigned long long candm = __ballot(cand);
        for (int rep_ = 0; rep_ < NSA_REP_SLT; ++rep_)
        for (int i = 0; i < 8; ++i) {
            const int tk = wid * 8 + i;
            const float v = ((imp[(0 * 64 + tk) * 65 + lane] + imp[(1 * 64 + tk) * 65 + lane]) + imp[(2 * 64 + tk) * 65 + lane]) + imp[(3 * 64 + tk) * 65 + lane];
            bool sel;
            if (n < 16) sel = (lane <= n);
            else {
                const unsigned key = __float_as_uint(v);
                unsigned T = 0u;
                for (int bit = 30; bit >= 0; --bit) { const unsigned Tt = T | (1u << bit); const unsigned long long ge = __ballot(key >= Tt) & candm; if (__builtin_popcountll(ge) >= 13) T = Tt; }
                const unsigned long long gtm = __ballot(key > T) & candm, eqm = __ballot(key == T) & candm;
                const int need = 13 - (int)__builtin_popcountll(gtm);
                const int eqrank = (int)__builtin_popcountll(eqm & ((1ull << lane) - 1ull));
                sel = (lane == 0) || (lane == n) || (lane == n - 1) || (cand && (key > T || (key == T && eqrank < need)));
            }
            const unsigned long long bal = __ballot(sel);
            if (lane == 0) selm[tk] = bal;
        }
    }
    ATT_SYNC();
    const unsigned long long myselm = ((LAS unsigned long long*)(lds + NSA_SELM))[tokl];
    acc_store(accp, oc, nullptr, wsf, gates[trow * 24 + hh * 3 + 0], r32, hi, false, nullptr);
    const LAS unsigned char* vpl = lds + NSA_LV + ((lane >> 4) & 1) * 32 + (lane & 3) * 8 + (4 * hi + ((lane & 15) >> 2)) * 64;
    bf16x8 kf[8]; s16x4 vf[8];
    {
        Soft ss;
        for (int rep_ = 0; rep_ < NSA_REP_SEL; ++rep_) {
        if (rep_) { ATT_SYNC(); dma_k(ks + (size_t)n * 64 * 64, 64, lds + NSA_LK, wid, lane); dma_v(vs + (size_t)n * 64 * 64, 64, lds + NSA_LV, wid, lane); ATT_SYNC(); }
        soft_init(ss);
        const int nt = n + 1;
        if (nt > 1) { dma_k(ks, 64, lds + NSA_LK + 8192, wid, lane); dma_v(vs, 64, lds + NSA_LV + 8192, wid, lane); }
        kload8(kf, lds + NSA_LK, r32, hi);
        int slot = 0;
        for (int i = 0; i < nt; ++i) {
            const int np = (i == 0) ? n : i - 1;
            const bool bit = (myselm >> np) & 1ull;
            f32x16 p0, p1;
            if (i == 0) qkt_reg<false>(p0, p1, kf, qr, 0.f); else qkt_reg<true>(p0, p1, kf, qr, bit ? -ss.m : NEGINF);
            ATT_SB(); vload8(vf, vpl + slot * 8192, 0); ATT_SB();
            if (i == 0) { mask_le(p0, p1, tokl, hi, NEGINF); soft_step<true>(ss, p0, p1, wsf, r32, hi); } else soft_step<false>(ss, p0, p1, wsf, r32, hi);
            const int s1 = (slot == 2) ? 0 : slot + 1;
            if (i + 1 < nt) {
                ATT_SB(); asm volatile("s_waitcnt vmcnt(0)" ::: "memory"); __builtin_amdgcn_s_barrier(); asm volatile("" ::: "memory");
                if (i + 2 < nt) { const int s2 = (slot == 0) ? 2 : slot - 1; dma_k(ks + (size_t)(i + 1) * 64 * 64, 64, lds + NSA_LK + s2 * 8192, wid, lane); dma_v(vs + (size_t)(i + 1) * 64 * 64, 64, lds + NSA_LV + s2 * 8192, wid, lane); }
                kload8(kf, lds + NSA_LK + s1 * 8192, r32, hi); ATT_SB();
            }
            pv_reg(ss.o, ss.lacc, vf, vpl + slot * 8192, p0, p1);
            slot = s1;
        }
        }
        acc_store(accp, ss.o, &ss.lacc, wsf, gates[trow * 24 + hh * 3 + 1], r32, hi, true, nullptr);
    }
    ATT_SYNC();
    {
        const bf16_t* kw = KV6 + 4 * KV6_STRIDE + bg * S_ * HD; const bf16_t* vw = KV6 + 5 * KV6_STRIDE + bg * S_ * HD;
        Soft sw;
        const int nt = (n >= 8) ? 9 : n + 1;
        for (int rep_ = 0; rep_ < NSA_REP_WIN; ++rep_) {
        if (rep_) ATT_SYNC();
        soft_init(sw);
        dma_k(kw + (size_t)n * 64 * 64, 64, lds + NSA_LK, wid, lane); dma_v(vw + (size_t)n * 64 * 64, 64, lds + NSA_LV, wid, lane);
        ATT_SYNC();
        if (nt > 1) { dma_k(kw + (size_t)(n - 1) * 64 * 64, 64, lds + NSA_LK + 8192, wid, lane); dma_v(vw + (size_t)(n - 1) * 64 * 64, 64, lds + NSA_LV + 8192, wid, lane); }
        kload8(kf, lds + NSA_LK, r32, hi);
        int slot = 0;
        for (int i = 0; i < nt; ++i) {
            f32x16 p0, p1;
            if (i == 0) qkt_reg<false>(p0, p1, kf, qr, 0.f); else qkt_reg<true>(p0, p1, kf, qr, -sw.m);
            ATT_SB(); vload8(vf, vpl + slot * 8192, 0); ATT_SB();
            if (i == 0) { mask_le(p0, p1, tokl, hi, NEGINF); soft_step<true>(sw, p0, p1, wsf, r32, hi); } else { if (i == 8) mask_gt(p0, p1, tokl, hi, NEGINF); soft_step<false>(sw, p0, p1, wsf, r32, hi); }
            const int s1 = (slot == 2) ? 0 : slot + 1;
            if (i + 1 < nt) {
                ATT_SB(); asm volatile("s_waitcnt vmcnt(0)" ::: "memory"); __builtin_amdgcn_s_barrier(); asm volatile("" ::: "memory");
                if (i + 2 < nt) { const int s2 = (slot == 0) ? 2 : slot - 1; const int nn = n - i - 2; dma_k(kw + (size_t)nn * 64 * 64, 64, lds + NSA_LK + s2 * 8192, wid, lane); dma_v(vw + (size_t)nn * 64 * 64, 64, lds + NSA_LV + s2 * 8192, wid, lane); }
                kload8(kf, lds + NSA_LK + s1 * 8192, r32, hi); ATT_SB();
            }
            pv_reg(sw.o, sw.lacc, vf, vpl + slot * 8192, p0, p1);
            slot = s1;
        }
        }
        acc_store(accp, sw.o, &sw.lacc, wsf, gates[trow * 24 + hh * 3 + 2], r32, hi, true, Y + ((size_t)b * S_ + 64 * n + 32 * th) * YP + hh * 64 + r32);
    }
}

constexpr int DL_LK = 0, DL_LV = 49152, DL_WSF = 98304;
__device__ __forceinline__ void dil_unit(LAS unsigned char* lds, int b, int g, int h, int res, int lb, const bf16_t* DIL, bf16_t* DILO, float* DLSE, int wid, int lane) {
    const int r32 = lane & 31, hi = lane >> 5;
    const int dil = (g == 0) ? 1 : (g == 1 ? 4 : 16);
    const size_t hb = ((size_t)(b * 4 + h) * S_) * HD;
    const bf16_t* Qb = DIL + (size_t)(g * 3 + 0) * DIL_STRIDE + hb; const bf16_t* Kb = DIL + (size_t)(g * 3 + 1) * DIL_STRIDE + hb; const bf16_t* Vb = DIL + (size_t)(g * 3 + 2) * DIL_STRIDE + hb;
    LAS float* wsf = (LAS float*)(lds + DL_WSF + wid * 256);
    const unsigned vb = (unsigned)(uintptr_t)(lds + DL_LV) + ((lane >> 4) & 1) * 32 + (lane & 3) * 8 + (4 * hi + ((lane & 15) >> 2)) * 64;
    const int L0 = 256 * lb - 128;
    __syncthreads();
    for (int ti = 0; ti < 6; ++ti) { const int Lr = L0 + 64 * ti; if (Lr < 0) continue;
        dma_k(Kb + (size_t)(res + dil * Lr) * HD, (size_t)dil * HD, lds + DL_LK + ti * 8192, wid, lane); dma_v(Vb + (size_t)(res + dil * Lr) * HD, (size_t)dil * HD, lds + DL_LV + ti * 8192, wid, lane); }
    const int Lq = 256 * lb + 32 * wid + r32;
    const size_t tq = (size_t)res + (size_t)dil * Lq;
    bf16x8 qr[4];
#pragma unroll
    for (int d0 = 0; d0 < 4; ++d0) qr[d0] = *(const bf16x8*)(Qb + tq * HD + d0 * 16 + hi * 8);
    ATT_SYNC();
    Soft ss; soft_init(ss);
    const int lim = 32 * (wid & 1) + r32;
    for (int k = 2; k >= 0; --k) {
        const int ti = (wid >> 1) + k;
        if (L0 + 64 * ti < 0) continue;
        f32x16 p0, p1;
        if (k == 2) { qkt<false>(p0, p1, lds + DL_LK + ti * 8192, qr, 0.f, r32, hi); mask_le(p0, p1, lim, hi, -INFINITY); soft_step<true>(ss, p0, p1, wsf, r32, hi); }
        else { qkt<true>(p0, p1, lds + DL_LK + ti * 8192, qr, -ss.m, r32, hi); if (k == 0) mask_gt(p0, p1, lim - 1, hi, -INFINITY); soft_step<false>(ss, p0, p1, wsf, r32, hi); }
        pv<true>(ss.o, ss.lacc, vb + ti * 8192, p0, p1);
    }
    if (r32 == 0) {
#pragma unroll
        for (int r = 0; r < 16; ++r) wsf[32 + crow(r, hi)] = ss.lacc[r]; }
    asm volatile("s_waitcnt lgkmcnt(0)" ::: "memory");
    if (hi == 0) DLSE[((size_t)g * T_ + (size_t)b * S_ + tq) * 4 + h] = ss.m + __builtin_amdgcn_logf(wsf[32 + r32]);
    bf16_t* ob = DILO + ((size_t)g * T_ + (size_t)b * S_ + res + (size_t)dil * (256 * lb + 32 * wid)) * 256 + h * 64 + r32;
#pragma unroll
    for (int r = 0; r < 16; ++r) { const int q = crow(r, hi); const float fr = __builtin_amdgcn_rcpf(ss.lacc[r]);
        ob[(size_t)q * dil * 256] = f2bf(ss.o[0][r] * fr); ob[(size_t)q * dil * 256 + 32] = f2bf(ss.o[1][r] * fr); }
    asm volatile("s_waitcnt lgkmcnt(0)" ::: "memory");
}
}
namespace peer {
using att::crow; using att::max3f; using att::swap_max;
constexpr int RT_TOPS = 32768, RT_TOPS_WAVE = 64 * 33 * 4;
__device__ __forceinline__ float drop_eq(float v, float M, float ninf) { float r; asm volatile("v_cmp_eq_f32 vcc, %1, %2\n\tv_cndmask_b32 %0, %2, %3, vcc" : "=v"(r) : "v"(M), "v"(v), "v"(ninf) : "vcc"); return r; }
__device__ __forceinline__ void cex(float& a, float& b) { const float hi_ = fmaxf(a, b), lo_ = fminf(a, b); a = hi_; b = lo_; }
__device__ __forceinline__ void bitonic_merge16(f32x16& v) {
#pragma unroll
    for (int j = 8; j >= 1; j >>= 1)
#pragma unroll
        for (int i = 0; i < 16; ++i) if ((i & j) == 0) { float a = v[i], b = v[i | j]; cex(a, b); v[i] = a; v[i | j] = b; }
}
__device__ __forceinline__ void sort16(f32x16& v) {
#pragma unroll
    for (int k = 2; k <= 16; k <<= 1)
#pragma unroll
        for (int j = k >> 1; j >= 1; j >>= 1)
#pragma unroll
            for (int i = 0; i < 16; ++i) { const int l = i ^ j; if (l > i) { float a = v[i], b = v[l]; const bool desc = ((i & k) == 0) || (k == 16); if (desc) cex(a, b); else cex(b, a); v[i] = a; v[l] = b; } }
}
__device__ __forceinline__ void merge_top16(f32x16& a, const f32x16& b) {
#pragma unroll
    for (int i = 0; i < 16; ++i) a[i] = fmaxf(a[i], b[15 - i]);
    bitonic_merge16(a);
}
__device__ __forceinline__ void route_unit(LAS unsigned char* lds, int tok0, int hp, const bf16_t* PQ, int* IDX, float* GS, int wid, int lane) {
    const int r32 = lane & 31, hi = lane >> 5;
    LAS float* tops = (LAS float*)(lds + RT_TOPS + wid * RT_TOPS_WAVE);
    const float NINF = -INFINITY; const unsigned hi4 = 4u * (unsigned)hi;
    bf16x8 qall[4][4];
#pragma unroll
    for (int rd = 0; rd < 4; ++rd)
#pragma unroll
        for (int d0 = 0; d0 < 4; ++d0) qall[rd][d0] = *(const bf16x8*)(PQ + (size_t)(tok0 + r32) * 1024 + (hp * 2 + (rd >> 1)) * 128 + (rd & 1) * 64 + d0 * 16 + hi * 8);
#pragma unroll
    for (int hl = 0; hl < 2; ++hl)
#pragma unroll
        for (int c = 0; c < 2; ++c) {
            const bf16x8 (&qr)[4] = qall[hl * 2 + c];
            f32x16 p[4];
            const LAS unsigned char* kbase = lds + c * 16384 + hi * 2048 + r32 * 16;
#pragma unroll
            for (int kb = 0; kb < 4; ++kb) {
                f32x16 z;
#pragma unroll
                for (int i = 0; i < 16; ++i) z[i] = 0.f;
#pragma unroll
                for (int d0 = 0; d0 < 4; ++d0) { const bf16x8 af = *(const LAS bf16x8*)(kbase + d0 * 4096 + kb * 512); p[kb] = __builtin_amdgcn_mfma_f32_32x32x16_bf16(af, qr[d0], d0 == 0 ? z : p[kb], 0, 0, 0); }
            }
            asm volatile("s_nop 15\n\ts_nop 7" : "+v"(p[0]), "+v"(p[1]), "+v"(p[2]), "+v"(p[3]));
#pragma unroll
            for (int kb = 0; kb < 4; ++kb)
#pragma unroll
                for (int r = 0; r < 16; ++r) { const unsigned K = 127u - 32u * kb - (unsigned)((r & 3) + 8 * (r >> 2)); p[kb][r] = __uint_as_float(((__float_as_uint(p[kb][r]) & 0xFFFFFF80u) | K) - hi4); }
            sort16(p[0]); sort16(p[1]); sort16(p[2]); sort16(p[3]);
            merge_top16(p[0], p[1]); merge_top16(p[2], p[3]); merge_top16(p[0], p[2]);
            {
                f32x16 q;
#pragma unroll
                for (int i = 0; i < 16; ++i) { auto rr = __builtin_amdgcn_permlane32_swap(__float_as_uint(p[0][i]), __float_as_uint(p[0][i]), false, false); q[i] = __uint_as_float(hi ? rr[0] : rr[1]); }
#pragma unroll
                for (int i = 0; i < 16; ++i) p[1][i] = fmaxf(p[0][i], q[15 - i]);
                bitonic_merge16(p[1]);
            }
            if (hi == 0) {
#pragma unroll
                for (int it = 0; it < 16; ++it) tops[(hl * 32 + r32) * 33 + c * 16 + it] = p[1][it]; }
        }
    asm volatile("s_waitcnt lgkmcnt(0)" ::: "memory");
    const LAS float* my = tops + lane * 33;
    float s1[16], s2[16];
#pragma unroll
    for (int k = 0; k < 16; ++k) { s1[k] = my[k]; s2[k] = my[16 + k]; }
    f32x16 cb[4];
    {
        int n = 0;
#pragma unroll
        for (int a = 0; a < 16; ++a)
#pragma unroll
            for (int b = 0; b < 16; ++b) if ((a + 1) * (b + 1) <= 16) { cb[n >> 4][n & 15] = __uint_as_float((__float_as_uint(s1[a] + s2[b]) & 0xFFFFFF00u) | (unsigned)(255 - (16 * a + b))); ++n; }
#pragma unroll
        for (int k = 50; k < 64; ++k) cb[k >> 4][k & 15] = NINF;
    }
    sort16(cb[0]); sort16(cb[1]); sort16(cb[2]); sort16(cb[3]);
    merge_top16(cb[0], cb[1]); merge_top16(cb[2], cb[3]); merge_top16(cb[0], cb[2]);
    float rk[16];
#pragma unroll
    for (int k = 0; k < 16; ++k) rk[k] = cb[0][k];
    float den = 0.f, ev[16];
#pragma unroll
    for (int k = 0; k < 16; ++k) { ev[k] = __expf(rk[k] - rk[0]); den += ev[k]; }
    const float inv = 1.f / den;
    const int t = tok0 + r32, h = hp * 2 + hi;
    int* ip = IDX + (size_t)t * 128 + h * 16; float* gp = GS + (size_t)t * 128 + h * 16;
#pragma unroll
    for (int k4 = 0; k4 < 4; ++k4) {
        u32x4 iv; f32x4 gv;
#pragma unroll
        for (int i = 0; i < 4; ++i) { const int k = k4 * 4 + i; const unsigned pid = 255u - (__float_as_uint(rk[k]) & 255u); const unsigned aa = pid >> 4, bb = pid & 15u;
            const unsigned i1 = 127u - (__float_as_uint(my[aa]) & 127u), i2 = 127u - (__float_as_uint(my[16 + bb]) & 127u); iv[i] = i1 * 128u + i2; gv[i] = ev[k] * inv; }
        *(u32x4*)(ip + k4 * 4) = iv; *(f32x4*)(gp + k4 * 4) = gv;
    }
    asm volatile("s_waitcnt lgkmcnt(0)" ::: "memory");
}

typedef float f32x2 __attribute__((ext_vector_type(2)));
constexpr float SU = 64.f, SV = 5.5f;
typedef unsigned u32x6 __attribute__((ext_vector_type(6)));
typedef float f32x32 __attribute__((ext_vector_type(32)));
constexpr int ROWB = 512;
constexpr int ROWBV = 512;
typedef __amdgpu_buffer_rsrc_t rsrc_t;
typedef int i32x8 __attribute__((ext_vector_type(8)));
template <int CTRL> __device__ __forceinline__ float dpp_mov(float x) { return __uint_as_float(__builtin_amdgcn_update_dpp(0, __float_as_uint(x), CTRL, 0xf, 0xf, false)); }
template <int EMASK> __device__ __forceinline__ void expert_lists(int X, int e_lo, int e_hi, float g_lo, float g_hi, int lane, LAS unsigned char* wl) {
    const int c_lo = (e_lo >> 3) & 15, c_hi = (e_hi >> 3) & 15; const unsigned long long lt = (1ull << lane) - 1ull;
    int base = 0, r_lo = 0, r_hi = 0;
    for (int c = 0; c < 16; ++c) { const unsigned long long mlo = __ballot(c_lo == c), mhi = __ballot(c_hi == c); const int nlo = (int)__builtin_popcountll(mlo);
        if (c_lo == c) r_lo = base + (int)__builtin_popcountll(mlo & lt);
        if (c_hi == c) r_hi = base + nlo + (int)__builtin_popcountll(mhi & lt);
        base += nlo + (int)__builtin_popcountll(mhi); }
    ((LAS int*)wl)[X * 128 + ((r_lo & ~7) | ((r_lo & 1) << 2) | ((r_lo >> 1) & 3))] = e_lo & EMASK; ((LAS int*)wl)[X * 128 + ((r_hi & ~7) | ((r_hi & 1) << 2) | ((r_hi >> 1) & 3))] = e_hi & EMASK;
    ((LAS float*)(wl + 1024))[X * 128 + r_lo] = g_lo; ((LAS float*)(wl + 1024))[X * 128 + r_hi] = g_hi;
}
__device__ __forceinline__ void expert_selector_table(LAS unsigned char* selT, int tid) {
    const int c = tid >> 5, m = tid & 31; const unsigned code = ((unsigned)(c >> 3) << 5) | 8u | (unsigned)(c & 7); const int pos = 6 * m, w0 = pos >> 5, sh = pos & 31;
    const unsigned lo = code << sh, hi = (sh > 26) ? (code >> (32 - sh)) : 0u; unsigned d[8];
#pragma unroll
    for (int w = 0; w < 8; ++w) d[w] = ((w == w0) ? lo : 0u) | ((w == w0 + 1) ? hi : 0u);
    *(LAS u32x4*)(selT + tid * 32) = (u32x4){d[0], d[1], d[2], d[3]}; *(LAS u32x4*)(selT + tid * 32 + 16) = (u32x4){d[4], d[5], d[6], d[7]};
}
template <int EMASK = 0xffff> __device__ __forceinline__ void expert_mfma4(int tA0, int tB0, int tA1, int tB1, const bf16_t* HN, const unsigned char* U8, const unsigned char* V8, const int* IDX, const float* GS, const float* SSQ, float* out, int lane, LAS unsigned char* hq, const LAS unsigned char* selT, LAS unsigned char* wl) {
    const rsrc_t ur = __builtin_amdgcn_make_buffer_rsrc((void*)U8, 0, 16 << 20, 0x00020000), vr = __builtin_amdgcn_make_buffer_rsrc((void*)V8, 0, 16 << 20, 0x00020000);
    const int h = lane >> 5, l31 = lane & 31, cb = l31 * 16;
    const int r = lane & 15, kb = lane >> 4, sl = r & 3, ca = 64 * kb + 16 * sl;
    const int tme0 = h ? tB0 : tA0, tme1 = h ? tB1 : tA1;
    const int e0[4] = {IDX[(size_t)tA0 * 128 + lane], IDX[(size_t)tA0 * 128 + 64 + lane], IDX[(size_t)tB0 * 128 + lane], IDX[(size_t)tB0 * 128 + 64 + lane]};
    const int e1[4] = {IDX[(size_t)tA1 * 128 + lane], IDX[(size_t)tA1 * 128 + 64 + lane], IDX[(size_t)tB1 * 128 + lane], IDX[(size_t)tB1 * 128 + 64 + lane]};
    const float g0[4] = {GS[(size_t)tA0 * 128 + lane], GS[(size_t)tA0 * 128 + 64 + lane], GS[(size_t)tB0 * 128 + lane], GS[(size_t)tB0 * 128 + 64 + lane]};
    const float g1[4] = {GS[(size_t)tA1 * 128 + lane], GS[(size_t)tA1 * 128 + 64 + lane], GS[(size_t)tB1 * 128 + lane], GS[(size_t)tB1 * 128 + 64 + lane]};
    const f32x4* sp0 = (const f32x4*)(SSQ + (size_t)tme0 * 16); const f32x4 sq0 = (sp0[0] + sp0[1]) + (sp0[2] + sp0[3]);
    const f32x4* sp1 = (const f32x4*)(SSQ + (size_t)tme1 * 16); const f32x4 sq1 = (sp1[0] + sp1[1]) + (sp1[2] + sp1[3]);
    u32x2 hw0[8], hw1[8];
    { const u32x2* hp0 = (const u32x2*)(HN + (size_t)tme0 * 1024 + 4 * l31); const u32x2* hp1 = (const u32x2*)(HN + (size_t)tme1 * 1024 + 4 * l31);
#pragma unroll
      for (int k = 0; k < 8; ++k) { hw0[k] = hp0[32 * k]; hw1[k] = hp1[32 * k]; } }
    f32x16 acc0A, acc0B, acc1A, acc1B;
#define EM_ACCIN(ACC, T) do { const int to_ = (EMASK == 0xffff) ? (T) : ((T) & 16383); const f32x4* o_ = (const f32x4*)(out + (size_t)to_ * 1024 + 128 * h + 4 * l31); \
        _Pragma("unroll") for (int rq = 0; rq < 4; ++rq) { const f32x4 v_ = o_[64 * rq]; _Pragma("unroll") for (int i = 0; i < 4; ++i) ACC[4 * rq + i] = v_[i]; } } while (0)
    EM_ACCIN(acc0A, tA0); EM_ACCIN(acc0B, tB0); EM_ACCIN(acc1A, tA1); EM_ACCIN(acc1B, tB1);
#undef EM_ACCIN
    expert_lists<EMASK>(0, e0[0], e0[1], g0[0], g0[1], lane, wl); expert_lists<EMASK>(1, e0[2], e0[3], g0[2], g0[3], lane, wl);
    expert_lists<EMASK>(0, e1[0], e1[1], g1[0], g1[1], lane, wl + 2048); expert_lists<EMASK>(1, e1[2], e1[3], g1[2], g1[3], lane, wl + 2048);
    u32x4 b40[2], b41[2]; u32x2 b20[2], b21[2];
#define EM_HB(HW, SQ, B4, B2) do { f32x16 ev, od; const float hs_ = 2.f * __builtin_amdgcn_rsqf(((SQ[0] + SQ[1]) + (SQ[2] + SQ[3])) * (1.f / 1024.f) + EPS); \
      _Pragma("unroll") for (int k = 0; k < 8; ++k) { const u32x2 w = HW[k]; ev[2 * k] = __builtin_amdgcn_fmed3f(hs_ * __uint_as_float(w[0] << 16), -7.5f, 7.5f); od[2 * k] = __builtin_amdgcn_fmed3f(hs_ * __uint_as_float(w[0] & 0xffff0000u), -7.5f, 7.5f); \
          ev[2 * k + 1] = __builtin_amdgcn_fmed3f(hs_ * __uint_as_float(w[1] << 16), -7.5f, 7.5f); od[2 * k + 1] = __builtin_amdgcn_fmed3f(hs_ * __uint_as_float(w[1] & 0xffff0000u), -7.5f, 7.5f); } \
      const u32x6 pk = __builtin_amdgcn_cvt_scalef32_2xpk16_fp6_f32(ev, od, 1.0f); \
      asm volatile("s_waitcnt lgkmcnt(0)" ::: "memory"); \
      *(LAS u32x4*)(hq + (h * 32 + l31) * 32) = (u32x4){pk[0], pk[1], pk[2], pk[3]}; *(LAS u32x2*)(hq + (h * 32 + l31) * 32 + 16) = (u32x2){pk[4], pk[5]}; \
      asm volatile("s_waitcnt lgkmcnt(0)" ::: "memory"); \
      _Pragma("unroll") for (int j = 0; j < 2; ++j) { const LAS unsigned char* bp = hq + ((((r >> 2) & 1) * 32) + 16 * j + 4 * kb + sl) * 32; B4[j] = *(const LAS u32x4*)bp; B2[j] = *(const LAS u32x2*)(bp + 16); } \
      asm volatile("s_waitcnt lgkmcnt(0)" ::: "memory"); } while (0)
    EM_HB(hw0, sq0, b40, b20); EM_HB(hw1, sq1, b41, b21);
#undef EM_HB
    u32x4 a4[8], vb[8];
    const LAS unsigned char* idA = wl + ((r >> 3) * 128 + ((r >> 2) & 1) * 4) * 4;
    const LAS unsigned char* idV0 = wl + (h * 4) * 4, * idV1 = wl + (128 + h * 4) * 4;
    const LAS unsigned char* gtp = wl + 1024 + (((lane >> 3) & 1) * 128 + (lane & 7)) * 4;
    LAS int* const pks = (LAS int*)(wl + 4096);
#define EM_LOADA(tk, LB) do { const u32x4 ia_ = *(const LAS u32x4*)(idA + (LB) + 32 * (tk)); _Pragma("unroll") for (int g = 0; g < 4; ++g) { const int ro_ = (int)((ia_[g] << 9) | (unsigned)ca); \
        _Pragma("unroll") for (int j = 0; j < 2; ++j) a4[2 * g + j] = __builtin_amdgcn_raw_buffer_load_b128(ur, ro_ + 256 * j, 0, 0); } } while (0)
#define EM_LOADV2(X, g, IV) do { vb[4 * (X) + (g)] = __builtin_amdgcn_raw_buffer_load_b128(vr, (int)((IV[g] << 9) | (unsigned)cb), 0, 0); } while (0)
#define EM_VMFMA(X, g, ACC) do { const int pk_ = pkc[4 * (X) + (g)]; const LAS unsigned char* sp_ = selT + (((unsigned)pk_ >> 8) & 15u) * 1024 + l31 * 32; const u32x4 s4_ = *(const LAS u32x4*)sp_; const u32x2 s2_ = *(const LAS u32x2*)(sp_ + 16); \
        const i32x8 As_ = {(int)s4_[0], (int)s4_[1], (int)s4_[2], (int)s4_[3], (int)s2_[0], (int)s2_[1], 0, 0}, Bv_ = {(int)vb[4 * (X) + (g)][0], (int)vb[4 * (X) + (g)][1], (int)vb[4 * (X) + (g)][2], (int)vb[4 * (X) + (g)][3], 0, 0, 0, 0}; \
        ACC = __builtin_amdgcn_mfma_scale_f32_32x32x64_f8f6f4(As_, Bv_, ACC, 2, 4, 0, pk_, 0, 0x7F7F7F7F); } while (0)
#define EM_VGROUP(g, PA, PB) do { EM_VMFMA(0, g, PA); EM_VMFMA(1, g, PB); asm volatile("" : "+v"(PA), "+v"(PB)); } while (0)
#define EM_STEP(tk, LB, B4, B2, PA, PB, NTK, NLB) do { \
        if ((LB) == 0) __builtin_amdgcn_s_barrier();       \
        float pd[4]; \
        _Pragma("unroll") for (int g = 0; g < 4; ++g) { f32x4 c = {0.f, 0.f, 0.f, 0.f}; \
            _Pragma("unroll") for (int j = 0; j < 2; ++j) { const i32x8 A = {(int)a4[2 * g + j][0], (int)a4[2 * g + j][1], (int)a4[2 * g + j][2], (int)a4[2 * g + j][3], 0, 0, 0, 0}, Bm = {(int)B4[j][0], (int)B4[j][1], (int)B4[j][2], (int)B4[j][3], (int)B2[j][0], (int)B2[j][1], 0, 0}; \
                c = __builtin_amdgcn_mfma_scale_f32_16x16x128_f8f6f4(A, Bm, c, 4, 2, 0, 0x7F7F7F7F, 0, 0x7E7E7E7E); } \
            pd[g] = (lane & 2) ? ((lane & 1) ? c[3] : c[2]) : ((lane & 1) ? c[1] : c[0]); } \
        asm volatile("" : "+v"(pd[0]), "+v"(pd[1]), "+v"(pd[2]), "+v"(pd[3])); \
        EM_LOADA(NTK, NLB); \
        const u32x4 iv0_ = *(const LAS u32x4*)(idV0 + (LB) + 32 * (tk)), iv1_ = *(const LAS u32x4*)(idV1 + (LB) + 32 * (tk)); const float gk_ = *(const LAS float*)(gtp + (LB) + 32 * (tk)); \
        _Pragma("unroll") for (int g = 0; g < 4; ++g) { pd[g] += dpp_mov<0xB1>(pd[g]); pd[g] += dpp_mov<0x4E>(pd[g]); } \
        const int sl_ = ((lane >> 3) & 1) * 36 + (lane & 1) * 16; \
        const float x0 = __shfl(pd[0], sl_), x1 = __shfl(pd[1], sl_), x2 = __shfl(pd[2], sl_), x3 = __shfl(pd[3], sl_); \
        __builtin_amdgcn_sched_barrier(0); \
        EM_VGROUP(0, PA, PB); EM_LOADV2(0, 0, iv0_); EM_LOADV2(1, 0, iv1_); \
        __builtin_amdgcn_sched_barrier(0); \
        const float dot_ = (lane & 4) ? ((lane & 2) ? x3 : x2) : ((lane & 2) ? x1 : x0); \
        const float act_ = gelu_tanh(dot_ * (1.f / SU)) * gk_ * (1.f / SV); \
        __builtin_amdgcn_sched_barrier(0); \
        EM_VGROUP(1, PA, PB); EM_LOADV2(0, 1, iv0_); EM_LOADV2(1, 1, iv1_); \
        __builtin_amdgcn_sched_barrier(0); \
        { const unsigned ab_ = __float_as_uint(act_), rb_ = (ab_ & 0x7fffffffu) + (1u << 19); pks[pkslot] = (int)((rb_ >> 23) | ((ab_ >> 31) << 11) | (((rb_ >> 20) & 7u) << 8)); } \
        __builtin_amdgcn_sched_barrier(0); \
        EM_VGROUP(2, PA, PB); EM_LOADV2(0, 2, iv0_); EM_LOADV2(1, 2, iv1_); \
        __builtin_amdgcn_sched_barrier(0); \
        asm volatile("s_waitcnt lgkmcnt(0)" ::: "memory"); \
        const u32x4 q0_ = *(const LAS u32x4*)(pks + 8 * h), q1_ = *(const LAS u32x4*)(pks + 8 * h + 4); \
        __builtin_amdgcn_sched_barrier(0); \
        EM_VGROUP(3, PA, PB); EM_LOADV2(0, 3, iv0_); EM_LOADV2(1, 3, iv1_); \
        __builtin_amdgcn_sched_barrier(0); \
        asm volatile("s_waitcnt lgkmcnt(0)" ::: "memory"); \
        _Pragma("unroll") for (int i = 0; i < 4; ++i) { pkc[i] = (int)q0_[i]; pkc[4 + i] = (int)q1_[i]; } } while (0)
    int pkc[8];
#pragma unroll
    for (int i = 0; i < 8; ++i) pkc[i] = 0;
    const int pkslot = (lane & 1) * 8 + ((lane >> 3) & 1) * 4 + ((lane >> 1) & 3) + 32 * (lane >> 4);
    asm volatile("s_waitcnt lgkmcnt(0)" ::: "memory");
    EM_LOADA(0, 0);
    { const u32x4 iv0_ = *(const LAS u32x4*)idV0, iv1_ = *(const LAS u32x4*)idV1; EM_LOADV2(0, 0, iv0_); EM_LOADV2(1, 0, iv1_); EM_LOADV2(0, 1, iv0_); EM_LOADV2(1, 1, iv1_); EM_LOADV2(0, 2, iv0_); EM_LOADV2(1, 2, iv1_); EM_LOADV2(0, 3, iv0_); EM_LOADV2(1, 3, iv1_); }
#pragma unroll 1
    for (int tk = 0; tk < 16; ++tk) {
        EM_STEP(tk, 0, b40, b20, acc1A, acc1B, tk, 2048);
        EM_STEP(tk, 2048, b41, b21, acc0A, acc0B, (tk + 1) & 15, 0);
    }
    EM_VGROUP(0, acc1A, acc1B); EM_VGROUP(1, acc1A, acc1B); __builtin_amdgcn_sched_barrier(0); EM_VGROUP(2, acc1A, acc1B); EM_VGROUP(3, acc1A, acc1B);
#undef EM_STEP
#undef EM_LOADA
#undef EM_LOADV2
#undef EM_VMFMA
#undef EM_VGROUP
#define EM_ACCOUT(ACC, T) do { const int to_ = (EMASK == 0xffff) ? (T) : ((T) & 16383); f32x4* o_ = (f32x4*)(out + (size_t)to_ * 1024 + 128 * h + 4 * l31); \
        _Pragma("unroll") for (int rq = 0; rq < 4; ++rq) o_[64 * rq] = (f32x4){ACC[4 * rq], ACC[4 * rq + 1], ACC[4 * rq + 2], ACC[4 * rq + 3]}; } while (0)
    EM_ACCOUT(acc0A, tA0); EM_ACCOUT(acc0B, tB0); EM_ACCOUT(acc1A, tA1); EM_ACCOUT(acc1B, tB1);
#undef EM_ACCOUT
}
}
constexpr int NWAVES = 8, NTHREADS = 512;
constexpr int RING_BYTES = 131072;
constexpr int LDS_BYTES = 147456;
constexpr int NPH = 11;

#ifndef DUP_MASK
#define DUP_MASK 0
#endif
#define RLX_AGENT __ATOMIC_RELAXED, __HIP_MEMORY_SCOPE_AGENT
#define XB_TMO      128
#define XB_XCNT(j)  (256  + 64 * (j))
#define XB_XSUB(j)  (1280 + 64 * (j))
#define XB_XGEN(j)  (2304 + 64 * (j))
#define XB_TOP      3328
#define XB_TOPGEN   3392
#define XCD_BAR_WORDS 3456
#define XB_SPIN_CAP (1u << 18)

__device__ __forceinline__ unsigned xb_ld(unsigned* p)              { return __hip_atomic_load(p, __ATOMIC_RELAXED, __HIP_MEMORY_SCOPE_AGENT); }
__device__ __forceinline__ unsigned xb_add(unsigned* p, unsigned v) { return __hip_atomic_fetch_add(p, v, __ATOMIC_RELAXED, __HIP_MEMORY_SCOPE_AGENT); }
__device__ __forceinline__ unsigned xb_xcc_id() { return (unsigned)__builtin_amdgcn_s_getreg((3 << 11) | 20) & 0xFu; }
#define XB_SPIN(cond, bar) do { unsigned _sp = 0; while (cond) { __builtin_amdgcn_s_sleep(1); \
    if ((++_sp & 255u) == 0u) { if (xb_ld(&(bar)[XB_TMO])) break; if (_sp > XB_SPIN_CAP) { atomicAdd(&(bar)[XB_TMO], 1u); break; } } } } while (0)

struct XcdBarrier {
    unsigned* bar; unsigned x;
    volatile LAS unsigned* st;
};

__device__ __forceinline__ XcdBarrier xcd_barrier_post(unsigned* bar, volatile LAS unsigned* st) {
    XcdBarrier b; b.bar = bar; b.x = xb_xcc_id(); b.st = st;
    if (threadIdx.x == 0) (void)xb_add(&bar[XB_XCNT(b.x)], 1u);
    return b;
}
__device__ __forceinline__ void xcd_barrier_complete(unsigned* bar, unsigned x, unsigned& nloc, unsigned& nx) {
    const unsigned G = gridDim.x * gridDim.y * gridDim.z;
    unsigned sum, cnt, mine, sp = 0u;
    for (;;) {
        sum = 0u; cnt = 0u; mine = 0u;
#pragma unroll
        for (unsigned j = 0; j < 16; ++j) { const unsigned c = xb_ld(&bar[XB_XCNT(j)]); sum += c; cnt += (c > 0u) ? 1u : 0u; mine = (j == x) ? c : mine; }
        if (sum == G) break;
        __builtin_amdgcn_s_sleep(1);
        if ((++sp & 255u) == 0u) { if (xb_ld(&bar[XB_TMO])) break; if (sp > XB_SPIN_CAP) { atomicAdd(&bar[XB_TMO], 1u); break; } }
    }
    nloc = mine > 0u ? mine : 1u; nx = cnt > 0u ? cnt : 1u;
}

__device__ __forceinline__ void xcd_barrier(const XcdBarrier& b) {
    asm volatile("s_waitcnt vmcnt(0)" ::: "memory");
    __syncthreads();
    if (threadIdx.x == 0) {
        unsigned* bar = b.bar;
        __builtin_amdgcn_s_waitcnt(0);
        unsigned nloc = b.st[0], nx = b.st[1];
        if (nloc == 0u) { xcd_barrier_complete(bar, b.x, nloc, nx); b.st[0] = nloc; b.st[1] = nx; }
        const unsigned old = xb_add(&bar[XB_XSUB(b.x)], 1u);
        const unsigned gen = old / nloc;
        if (old + 1u == (gen + 1u) * nloc) {
            __builtin_amdgcn_fence(__ATOMIC_RELEASE, "agent");
            asm volatile("s_waitcnt vmcnt(0)" ::: "memory");
            const unsigned og = xb_add(&bar[XB_TOP], 1u);
            const unsigned tg = og / nx;
            if (og + 1u == (tg + 1u) * nx) xb_add(&bar[XB_TOPGEN], 1u);
            else XB_SPIN(xb_ld(&bar[XB_TOPGEN]) == tg, bar);
            __builtin_amdgcn_fence(__ATOMIC_ACQUIRE, "agent");
            xb_add(&bar[XB_XGEN(b.x)], 1u);
            asm volatile("s_waitcnt vmcnt(0)" ::: "memory");
        } else {
            XB_SPIN(xb_ld(&bar[XB_XGEN(b.x)]) == gen, bar);
            __builtin_amdgcn_fence(__ATOMIC_ACQUIRE, "agent");
            asm volatile("s_waitcnt vmcnt(0)" ::: "memory");
        }
    }
    __syncthreads();
}
constexpr int MISC_OFF = LDS_BYTES - 64;
struct Args { const float* in[21]; float* out; unsigned char* ws; int ph_lo, ph_hi, dup, pad; };

struct Frame { LAS unsigned char* lds; int tid, lane, wave, G, vcu, gw, NGW; };

#define LDS_WAIT() asm volatile("s_waitcnt lgkmcnt(0)" ::: "memory")

__device__ __forceinline__ void p0_transpose_item(const float* W, int ldw, int skip_at, int skip, bf16_t* WT, int ldo, int koff, int nblk, LAS float* scr, int item, int lane, const float* kscale = nullptr) {
    const int kb = item / nblk, nb = item % nblk, k0 = 64 * kb, n0 = 32 * nb;
    const int nsrc = n0 + (lane & 31) + ((n0 >= skip_at) ? skip : 0);
#pragma unroll 8
    for (int i = 0; i < 32; ++i) { const int kk = 2 * i + (lane >> 5); float w_ = W[(size_t)(k0 + kk) * ldw + nsrc]; if (kscale) w_ *= kscale[k0 + kk]; scr[kk * 33 + (lane & 31)] = w_; }
    LDS_WAIT(); asm volatile("" ::: "memory");
    const int c = lane & 7;
#pragma unroll
    for (int j = 0; j < 4; ++j) { const int n = (lane >> 3) + 8 * j; const LAS float* s = scr + (8 * c) * 33 + n;
        u32x4 o; o.x = pk2(s[0 * 33], s[1 * 33]); o.y = pk2(s[2 * 33], s[3 * 33]); o.z = pk2(s[4 * 33], s[5 * 33]); o.w = pk2(s[6 * 33], s[7 * 33]);
        *(u32x4*)(WT + (size_t)(n0 + n) * ldo + koff + k0 + 8 * c) = o; }
    LDS_WAIT(); asm volatile("" ::: "memory");
}

__device__ __forceinline__ void norm_rows4(const float* src, const float* gain, bf16_t* dst, int gw, int NGW, int lane) {
    f32x4 gv[4];
#pragma unroll
    for (int j = 0; j < 4; ++j) gv[j] = ((const f32x4*)gain)[lane + 64 * j];
    for (int row0 = gw * 4; row0 < T_; row0 += NGW * 4) {
        f32x4 v[4][4]; float ss[4];
#pragma unroll
        for (int r = 0; r < 4; ++r) { const f32x4* xr = (const f32x4*)(src + (size_t)(row0 + r) * D_);
#pragma unroll
            for (int j = 0; j < 4; ++j) v[r][j] = xr[lane + 64 * j]; }
#pragma unroll
        for (int r = 0; r < 4; ++r) { ss[r] = 0.f;
#pragma unroll
            for (int j = 0; j < 4; ++j) ss[r] += v[r][j].x * v[r][j].x + v[r][j].y * v[r][j].y + v[r][j].z * v[r][j].z + v[r][j].w * v[r][j].w; }
#pragma unroll
        for (int o = 1; o < 64; o <<= 1) {
#pragma unroll
            for (int r = 0; r < 4; ++r) ss[r] += __shfl_xor(ss[r], o); }
#pragma unroll
        for (int r = 0; r < 4; ++r) { const float rstd = rsqrtf(ss[r] * (1.f / D_) + EPS);
#pragma unroll
            for (int j = 0; j < 4; ++j) { const f32x4 w = v[r][j] * rstd * gv[j]; u32x2 o; o.x = pk2(w.x, w.y); o.y = pk2(w.z, w.w); ((u32x2*)(dst + (size_t)(row0 + r) * D_))[lane + 64 * j] = o; } }
    }
}

template <bool G2> __device__ __forceinline__ void fp4_table(const f32x4* src, const f32x4* g2v, unsigned char* dst, float sc, int gt, int NGT) {
    for (int i = gt; i < 16384 * 32; i += NGT) { const int row = i >> 5, j = i & 31; f32x4 v[8];
#pragma unroll
        for (int k = 0; k < 8; ++k) v[k] = src[(size_t)row * 256 + 32 * k + j];
        if (G2) {
#pragma unroll
            for (int k = 0; k < 8; ++k) v[k] = v[k] * g2v[32 * k + j]; }
        u32x4 pk = {0u, 0u, 0u, 0u};
#pragma unroll
        for (int w = 0; w < 4; ++w) { unsigned x = 0u;
            x = __builtin_amdgcn_cvt_scalef32_pk_fp4_f32(x, v[2 * w][0] * sc, v[2 * w][1] * sc, 1.0f, 0); x = __builtin_amdgcn_cvt_scalef32_pk_fp4_f32(x, v[2 * w][2] * sc, v[2 * w][3] * sc, 1.0f, 1);
            x = __builtin_amdgcn_cvt_scalef32_pk_fp4_f32(x, v[2 * w + 1][0] * sc, v[2 * w + 1][1] * sc, 1.0f, 2); x = __builtin_amdgcn_cvt_scalef32_pk_fp4_f32(x, v[2 * w + 1][2] * sc, v[2 * w + 1][3] * sc, 1.0f, 3); pk[w] = x; }
        *(u32x4*)(dst + (size_t)row * 512 + 16 * j) = pk; }
}
__device__ __forceinline__ void phase0(const Frame& F, const Args& a) {
    unsigned char* ws = a.ws;
    const float* x = a.in[0]; const float* g1 = a.in[1]; const float* w_in = a.in[2];
    {
        LAS float* scr = (LAS float*)(F.lds + F.wave * 16384);
        constexpr int I_IN = 16 * 176, I_UPN = 8 * 32, I_UPD = 4 * 32, I_O = 16 * 32, I_Q = 16 * 32, I_C1 = 32 * 8;
        constexpr int NITEMS = I_IN + I_UPN + I_UPD + I_O + I_Q + 2 * I_C1;
        for (int it = F.gw; it < NITEMS; it += F.NGW) {
            int r = it;
            if (r < I_IN) { p0_transpose_item(w_in, IN_COLS, 1280, 24, (bf16_t*)(ws + WS_WTIN), 1024, 0, 176, scr, r, F.lane); continue; } r -= I_IN;
            if (r < I_UPN) { p0_transpose_item(a.in[13], 1024, 1 << 30, 0, (bf16_t*)(ws + WS_WTCAT), YP, 0, 32, scr, r, F.lane); continue; } r -= I_UPN;
            if (r < I_UPD) { p0_transpose_item(a.in[14], 1024, 1 << 30, 0, (bf16_t*)(ws + WS_WTCAT), YP, 512, 32, scr, r, F.lane); continue; } r -= I_UPD;
            if (r < I_O) { p0_transpose_item(a.in[15], 1024, 1 << 30, 0, (bf16_t*)(ws + WS_WTO), 1024, 0, 32, scr, r, F.lane); continue; } r -= I_O;
            if (r < I_Q) { p0_transpose_item(a.in[17], 1024, 1 << 30, 0, (bf16_t*)(ws + WS_WTQ), 1024, 0, 32, scr, r, F.lane, a.in[16]); continue; } r -= I_Q;
            if (r < I_C1) { p0_transpose_item(a.in[6], 256, 1 << 30, 0, (bf16_t*)(ws + WS_WTC1K), 2048, 0, 8, scr, r, F.lane); continue; } r -= I_C1;
            p0_transpose_item(a.in[9], 256, 1 << 30, 0, (bf16_t*)(ws + WS_WTC1V), 2048, 0, 8, scr, r, F.lane);
        }
    }
    {
        const int gt = F.vcu * NTHREADS + F.tid, NGT = F.G * NTHREADS;
        float* rope = (float*)(ws + WS_ROPE);
        for (int id = gt; id < S_ * 8; id += NGT) {
            const int pos = id >> 3, i = id & 7;
            const float inv = (float)pow(500000.0, -(double)i / 8.0);
            const float ang = (float)pos * inv;
            const double rev = (double)ang * 0.15915494309189535;
            const double fr = rev - floor(rev);
            const float aa = (float)(fr * 6.283185307179586);
            rope[pos * 16 + i] = __cosf(aa); rope[pos * 16 + 8 + i] = __sinf(aa);
        }
        bf16_t* sk = (bf16_t*)(ws + WS_SUBK); const float* subkeys = a.in[18];
        for (int id = gt; id < 2 * 128 * 64; id += NGT) { const int c = id >> 13, n = (id >> 6) & 127, d = id & 63; sk[(size_t)c * 8192 + (d >> 3) * 1024 + n * 8 + (d & 7)] = f2bf(subkeys[id]); }
        const int task = F.NGW - 1 - F.gw;
        if (task < 256) { const int which = task >> 7, kc = (task >> 2) & 31, n = (task & 3) * 64 + F.lane; const float* pe = (which ? a.in[8] : a.in[5]) + kc * 64; const float* w1 = (which ? a.in[9] : a.in[6]) + (size_t)kc * 64 * 256 + n;
            float s0 = 0.f, s1 = 0.f, s2 = 0.f, s3 = 0.f;
#pragma unroll
            for (int k = 0; k < 64; k += 4) { s0 += pe[k] * w1[(size_t)k * 256]; s1 += pe[k + 1] * w1[(size_t)(k + 1) * 256]; s2 += pe[k + 2] * w1[(size_t)(k + 2) * 256]; s3 += pe[k + 3] * w1[(size_t)(k + 3) * 256]; }
            ((float*)(ws + WS_BIAS1))[(which * 32 + kc) * 256 + n] = (s0 + s1) + (s2 + s3); }
        { float* gt_ = (float*)(ws + WS_GAINS); for (int id = gt; id < 640; id += NGT) gt_[id] = (id < 64) ? a.in[3][id] : (id < 256) ? a.in[4][id - 64] : (id < 448) ? a.in[11][id - 256] : a.in[12][id - 448]; }
        bf16_t* w2t = (bf16_t*)(ws + WS_W2T);
        for (int id = gt; id < 2 * 64 * 256; id += NGT) { const int which = id >> 14, d = (id >> 8) & 63, n = id & 255; w2t[id] = f2bf((which ? a.in[10] : a.in[7])[n * 64 + d]); }
    }
    {
        const int gt = F.vcu * NTHREADS + F.tid, NGT = F.G * NTHREADS;
        fp4_table<true>((const f32x4*)a.in[19], (const f32x4*)a.in[16], ws + WS_U, peer::SU, gt, NGT);
        fp4_table<false>((const f32x4*)a.in[20], (const f32x4*)a.in[16], ws + WS_U + 16 * MiB, peer::SV, gt, NGT);
    }
    {
        const int gt = F.vcu * NTHREADS + F.tid, NGT = F.G * NTHREADS; bf16_t* wgt = (bf16_t*)(ws + WS_WG);
        for (int id = gt; id < 32 * 1024; id += NGT) { const int c = id >> 10, k = id & 1023; wgt[id] = (c < 24) ? f2bf(w_in[(size_t)k * IN_COLS + 1280 + c]) : (bf16_t)0; }
    }
    norm_rows4(x, g1, (bf16_t*)(ws + WS_H), F.gw, F.NGW, F.lane);
}


__device__ __forceinline__ void phase2(const Args& a, LAS unsigned char* lds, int vcu, int G, int wave, int lane) {
    unsigned char* ws = a.ws;
    const bf16_t* KV6 = (const bf16_t*)(ws + WS_KV6);
    const int fr = lane & 15, fq = lane >> 4;
    for (int tp = vcu; tp < 256; tp += G) { const int t2 = tp * 2 + (wave >> 2);
        const int which = t2 >> 8, t = t2 & 255, r0 = (t >> 2) * 64, c0 = (t & 3) * 64, bg = r0 >> 8, i0 = r0 & 255, kq = wave & 3;
        const bf16_t* A = KV6 + (size_t)which * KV6_STRIDE + ((size_t)bg * S_ + 16 * i0) * HD + 512 * kq;
        const bf16_t* Bt = (const bf16_t*)(ws + (which ? WS_WTC1V : WS_WTC1K)) + (size_t)c0 * 2048 + 512 * kq;
        const float* bp1 = (const float*)(ws + WS_BIAS1) + which * 32 * 256 + c0 + fr; bf16_t* HID = (bf16_t*)(ws + WS_HID) + (size_t)which * 4096 * 256;
        float bsum[4] = {0.f, 0.f, 0.f, 0.f};
#pragma unroll
        for (int kc = 0; kc < 32; ++kc) {
#pragma unroll
            for (int ni = 0; ni < 4; ++ni) bsum[ni] += bp1[kc * 256 + 16 * ni]; }
        f32x4 acc[4][4]; ZERO_ACC(acc);
        wave_gemm64(A, 1024, Bt, 2048, 512, acc, lane);
        __syncthreads();
        LAS float* mine = (LAS float*)(lds + wave * 16384) + lane;
#pragma unroll
        for (int mi = 0; mi < 4; ++mi)
#pragma unroll
            for (int ni = 0; ni < 4; ++ni)
#pragma unroll
                for (int j = 0; j < 4; ++j) mine[((mi * 4 + ni) * 4 + j) * 64] = acc[mi][ni][j];
        __syncthreads();
        const LAS float* grp = (const LAS float*)(lds + (wave & 4) * 16384) + lane;
#pragma unroll
        for (int ni = 0; ni < 4; ++ni)
#pragma unroll
            for (int j = 0; j < 4; ++j) { const int e = ((kq * 4 + ni) * 4 + j) * 64;
                const float v = (grp[e] + grp[e + 4096]) + (grp[e + 8192] + grp[e + 12288]);
                const int row = r0 + 16 * kq + 4 * fq + j, col = c0 + 16 * ni + fr;
                HID[(size_t)row * 256 + col] = f2bf(gelu_tanh(v + bsum[ni])); }
    }
    {
        const bf16_t* H = (const bf16_t*)(ws + WS_H); const bf16_t* WG = (const bf16_t*)(ws + WS_WG); float* gates = (float*)(ws + WS_GATES);
        for (int tile = vcu * 8 + wave; tile < T_ / 16; tile += G * 8) {
            const bf16_t* ap = WG + (size_t)fr * 1024 + fq * 8; const bf16_t* bp = H + (size_t)(tile * 16 + fr) * 1024 + fq * 8;
            f32x4 c0 = {0.f, 0.f, 0.f, 0.f}, c1 = c0;
#pragma unroll 8
            for (int ks = 0; ks < 32; ++ks) { const bf16x8 b = *(const bf16x8*)(bp + ks * 32);
                c0 = __builtin_amdgcn_mfma_f32_16x16x32_bf16(*(const bf16x8*)(ap + ks * 32), b, c0, 0, 0, 0);
                c1 = __builtin_amdgcn_mfma_f32_16x16x32_bf16(*(const bf16x8*)(ap + 16 * 1024 + ks * 32), b, c1, 0, 0, 0); }
            float* gp = gates + (size_t)(tile * 16 + fr) * 24 + 4 * fq;
#pragma unroll
            for (int j = 0; j < 4; ++j) { gp[j] = sigmoidf_(c0[j]); if (fq < 2) gp[16 + j] = sigmoidf_(c1[j]); }
        }
    }
}
__device__ __forceinline__ void cmp2_tasks(const Args& a, int gw, int NGW, int lane) {
    unsigned char* ws = a.ws; const float* rope = (const float*)(ws + WS_ROPE); const float* nsa_kn = a.in[4];
    const int fr = lane & 15;
    for (int id = gw; id < 128; id += NGW) {
        const int which = id >> 6, r0 = (id & 63) * 64;
        f32x4 acc[4][4]; ZERO_ACC(acc);
        wave_gemm64((const bf16_t*)(ws + WS_HID) + ((size_t)which * 4096 + r0) * 256, 256, (const bf16_t*)(ws + WS_W2T) + (size_t)which * 64 * 256, 256, 256, acc, lane);
        if (which == 1) {
            bf16_t* VC = (bf16_t*)(ws + WS_VCMP);
            FOR_ACC(acc, r0, 0, lane, VC[(size_t)row * 64 + col] = ((row & 255) < NCMP) ? f2bf(val) : (bf16_t)0; )
        } else {
            bf16_t* KC = (bf16_t*)(ws + WS_KCMP);
#pragma unroll
            for (int mi = 0; mi < 4; ++mi)
#pragma unroll
                for (int j = 0; j < 4; ++j) {
                    const int row = r0 + 16 * mi + 4 * (lane >> 4) + j, i = row & 255;
                    float ss = acc[mi][0][j] * acc[mi][0][j] + acc[mi][1][j] * acc[mi][1][j] + acc[mi][2][j] * acc[mi][2][j] + acc[mi][3][j] * acc[mi][3][j];
                    ss += __shfl_xor(ss, 1); ss += __shfl_xor(ss, 2); ss += __shfl_xor(ss, 4); ss += __shfl_xor(ss, 8);
                    const float rstd = rsqrtf(ss * (1.f / 64.f) + EPS);
                    float z[4];
#pragma unroll
                    for (int ni = 0; ni < 4; ++ni) z[ni] = acc[mi][ni][j] * rstd * nsa_kn[16 * ni + fr];
                    const float pz = __shfl_xor(z[0], 8); const int pos = (16 * i + 31) & 4095;
                    const float c = rope[pos * 16 + (fr & 7)], sn = rope[pos * 16 + 8 + (fr & 7)];
                    z[0] = (fr < 8) ? (z[0] * c - pz * sn) : (pz * sn + z[0] * c);
#pragma unroll
                    for (int ni = 0; ni < 4; ++ni) KC[(size_t)row * 64 + 16 * ni + fr] = (i < NCMP) ? f2bf(z[ni]) : (bf16_t)0;
                }
        }
    }
}
__device__ __forceinline__ void dil_combine(const Args& a, int gt, int NGT) {
    unsigned char* ws = a.ws; const bf16_t* DILO = (const bf16_t*)(ws + WS_DILO); const float* DLSE = (const float*)(ws + WS_DLSE); bf16_t* Y = (bf16_t*)(ws + WS_Y);
    for (int idx = gt; idx < T_ * 32; idx += NGT) {
        const int t = idx >> 5, c = idx & 31, h = c >> 3;
        const float l0 = DLSE[((size_t)0 * T_ + t) * 4 + h], l1 = DLSE[((size_t)1 * T_ + t) * 4 + h], l2 = DLSE[((size_t)2 * T_ + t) * 4 + h];
        const float mx = fmaxf(l0, fmaxf(l1, l2)); float w0 = __builtin_amdgcn_exp2f(l0 - mx), w1 = __builtin_amdgcn_exp2f(l1 - mx), w2 = __builtin_amdgcn_exp2f(l2 - mx);
        const float inv = 1.f / (w0 + w1 + w2); w0 *= inv; w1 *= inv; w2 *= inv;
        const u32x4 o0 = *(const u32x4*)(DILO + ((size_t)0 * T_ + t) * 256 + c * 8), o1 = *(const u32x4*)(DILO + ((size_t)1 * T_ + t) * 256 + c * 8), o2 = *(const u32x4*)(DILO + ((size_t)2 * T_ + t) * 256 + c * 8);
        u32x4 o;
#pragma unroll
        for (int i = 0; i < 4; ++i) {
            const float lo = w0 * __uint_as_float(o0[i] << 16) + w1 * __uint_as_float(o1[i] << 16) + w2 * __uint_as_float(o2[i] << 16);
            const float hi = w0 * __uint_as_float(o0[i] & 0xffff0000u) + w1 * __uint_as_float(o1[i] & 0xffff0000u) + w2 * __uint_as_float(o2[i] & 0xffff0000u);
            o[i] = pk2(lo, hi); }
        *(u32x4*)(Y + (size_t)t * YP + 512 + c * 8) = o;
    }
}
__device__ __forceinline__ void phase7(const Args& a, int gw, int NGW, int lane) { norm_rows4(a.out, a.in[16], (bf16_t*)(a.ws + WS_HN), gw, NGW, lane); }

__global__ void __launch_bounds__(NTHREADS, 2) mega_fwd(Args a) {
    extern __shared__ __attribute__((aligned(16))) unsigned char lds_raw[];
    Frame F;
    F.lds = (LAS unsigned char*)lds_raw;
    F.tid = threadIdx.x; F.lane = F.tid & 63; F.wave = __builtin_amdgcn_readfirstlane(F.tid >> 6);
    F.G = gridDim.x; { const int bx = blockIdx.x; F.vcu = (F.G % 8 == 0) ? (bx % 8) * (F.G / 8) + bx / 8 : bx; }
    F.gw = F.vcu * NWAVES + F.wave; F.NGW = F.G * NWAVES;
    unsigned char* ws = a.ws;
    const int lo = a.ph_lo, hi = a.ph_hi;
#ifndef PHASE_MASK
#define PHASE_MASK 0x7ff
#endif
#define IN(k) (((PHASE_MASK >> (k)) & 1) && lo <= (k) && (k) < hi)
    volatile LAS unsigned* MISC = (volatile LAS unsigned*)(F.lds + MISC_OFF);
    if (F.tid < 16) MISC[F.tid] = 0u;
    unsigned* barw = (unsigned*)(ws + WS_CTL);
    if (IN(0) && blockIdx.x == 0) { for (int i = F.tid; i < XCD_BAR_WORDS; i += NTHREADS) __hip_atomic_store(barw + i, 0u, RLX_AGENT); }
    __syncthreads();
    XcdBarrier bar; bar.bar = barw; bar.x = 0; bar.st = MISC;
#define SEAM(k) do { if (IN(k) && IN((k) + 1)) { if ((k) == 0) { cg::this_grid().sync(); bar = xcd_barrier_post(barw, MISC); } else xcd_barrier(bar); } } while (0)

#define DUPQ(k) ((DUP_MASK >> (k)) & 1)
#define RUN(k, ...) do { if (IN(k)) { __VA_ARGS__ if constexpr (DUPQ(k)) { xcd_barrier(bar); __VA_ARGS__ } } } while (0)
    if (IN(0)) { phase0(F, a); if constexpr (DUPQ(0)) { __syncthreads(); phase0(F, a); } } SEAM(0);
#define P1_BODY { pg8::Gemm g{(const bf16_t*)(ws + WS_H), (const bf16_t*)(ws + WS_WTIN), T_, NIN, D_}; pg8::StaticOrder S; S.init(T_, NIN, F.G, (int)blockIdx.x); \
        pg8::EpiInproj E{ws, (bf16_t*)a.out, -1, (LAS float*)(F.lds + RING_BYTES)}; \
        pg8::gemm_phase<pg8::EpiInproj, pg8::StaticOrder, true, true>(F.lds, g, S, E); }
    RUN(1, P1_BODY); SEAM(1);
    RUN(2, phase2(a, F.lds, F.vcu, F.G, F.wave, F.lane); ); SEAM(2);
    RUN(3,
        cmp2_tasks(a, F.gw, F.NGW, F.lane);
        for (int uid = F.vcu; uid < 1536; uid += F.G) { const int sub = uid & 15, h = (uid >> 4) & 3, bg = uid >> 6, g = bg % 3, b = bg / 3;
            const int res = (g == 0) ? 0 : (g == 1 ? (sub & 3) : sub), lb = (g == 0) ? sub : (g == 1 ? (sub >> 2) : 0);
            att::dil_unit(F.lds, b, g, h, res, lb, (const bf16_t*)(ws + WS_DIL), (bf16_t*)(ws + WS_DILO), (float*)(ws + WS_DLSE), F.wave, F.lane); } ); SEAM(3);
    RUN(4,
        dil_combine(a, F.vcu * NTHREADS + F.tid, F.G * NTHREADS);
        for (int i = F.vcu; i < 1024; i += F.G) { const int k = i >> 8, v = i & 255, bgi = v >> 4, s = v & 15;
            const int n = (k == 0) ? s : (k == 1) ? 63 - s : (k == 2) ? 16 + s : 47 - s;
            att::nsa_unit(F.lds, bgi >> 1, bgi & 1, n, (const bf16_t*)(ws + WS_QN), (const bf16_t*)(ws + WS_KV6), (const bf16_t*)(ws + WS_KCMP), (const bf16_t*)(ws + WS_VCMP), (const float*)(ws + WS_GATES), (bf16_t*)(ws + WS_Y), F.wave, F.lane); } ); SEAM(4);
    RUN(5, { pg8::Gemm g{(const bf16_t*)(ws + WS_Y), (const bf16_t*)(ws + WS_WTCAT), T_, D_, YP}; pg8::StaticOrder S; S.init(T_, D_, F.G, (int)blockIdx.x);
        pg8::EpiMerge E{(const bf16_t*)a.out, (bf16_t*)(ws + WS_MERGED), 8};
        pg8::gemm_phase<pg8::EpiMerge, pg8::StaticOrder, true, true>(F.lds, g, S, E); } ); SEAM(5);
    RUN(6, { pg8::Gemm g{(const bf16_t*)(ws + WS_MERGED), (const bf16_t*)(ws + WS_WTO), T_, D_, D_}; pg8::StaticOrder S; S.init(T_, D_, F.G, (int)blockIdx.x);
        pg8::EpiWo E{a.in[0], a.out, -1, (bf16_t*)(ws + WS_HN), (float*)(ws + WS_SSQ)};
        pg8::gemm_phase<pg8::EpiWo, pg8::StaticOrder, true, true>(F.lds, g, S, E); } ); SEAM(6);
    RUN(8, { pg8::Gemm g{(const bf16_t*)(ws + WS_HN), (const bf16_t*)(ws + WS_WTQ), T_, D_, D_}; pg8::StaticOrder S; S.init(T_, D_, F.G, (int)blockIdx.x);
        pg8::EpiPQ E{(bf16_t*)(ws + WS_PQ), (const float*)(ws + WS_SSQ), -1};
        pg8::gemm_phase<pg8::EpiPQ, pg8::StaticOrder, true, true>(F.lds, g, S, E); } ); SEAM(8);
    RUN(9,
        { const u32x4* src = (const u32x4*)(ws + WS_SUBK); LAS u32x4* dst = (LAS u32x4*)F.lds; for (int i = F.tid; i < 2048; i += NTHREADS) dst[i] = src[i]; }
        __syncthreads();
        for (int u = F.gw; u < 4096; u += F.NGW) peer::route_unit(F.lds, (u >> 2) * 32, u & 3, (const bf16_t*)(ws + WS_PQ), (int*)(ws + WS_IDX), (float*)(ws + WS_GS), F.wave, F.lane); ); SEAM(9);
    if (IN(10)) {
        peer::expert_selector_table((LAS unsigned char*)(F.lds + 98304), F.tid);
        for (int t = F.gw; t + 3 * F.NGW < T_; t += 4 * F.NGW) {
            __syncthreads();
            peer::expert_mfma4(t, t + F.NGW, t + 2 * F.NGW, t + 3 * F.NGW, (const bf16_t*)(ws + WS_HN), (const unsigned char*)(ws + WS_U), (const unsigned char*)(ws + WS_U + 16 * MiB), (const int*)(ws + WS_IDX), (const float*)(ws + WS_GS), (const float*)(ws + WS_SSQ), a.out, F.lane,
                              (LAS unsigned char*)(F.lds + 8192 + F.wave * 2048), (const LAS unsigned char*)(F.lds + 98304), (LAS unsigned char*)(F.lds + 32768 + F.wave * 8192)); }
    }
#undef IN
#undef SEAM
}
#ifndef DUP_MASK
#define DUP_MASK 0
#endif
static int g_grid = 0;
static void launch_mega(const Args& base, int lo, int hi, hipStream_t stream) {
    Args a = base; a.ph_lo = lo; a.ph_hi = hi;
    if (hi - lo > 1) {
        void* args[] = {&a};
        hipError_t e = hipLaunchCooperativeKernel((const void*)mega_fwd, dim3(g_grid), dim3(NTHREADS), args, LDS_BYTES, stream);
        if (e != hipSuccess) fprintf(stderr, "cooperative launch failed: %s (grid %d)\n", hipGetErrorString(e), g_grid);
    } else {
        hipLaunchKernelGGL(mega_fwd, dim3(g_grid), dim3(NTHREADS), LDS_BYTES, stream, a);
    }
}
extern "C" void kernel_launch(void* const* d_in, const int* in_sizes, int n_in, void* d_out, int out_size, void* d_ws, size_t ws_size, hipStream_t stream) {
    if (n_in != 21 || ws_size < WS_END) { fprintf(stderr, "kernel_launch: unexpected n_in %d / ws_size %zu (need %zu)\n", n_in, ws_size, (size_t)WS_END); return; }
    if (g_grid == 0) {
        int dev = 0, cus = 0, per_cu = 0;
        (void)hipGetDevice(&dev); (void)hipDeviceGetAttribute(&cus, hipDeviceAttributeMultiprocessorCount, dev);
        (void)hipFuncSetAttribute((const void*)mega_fwd, hipFuncAttributeMaxDynamicSharedMemorySize, LDS_BYTES);
        (void)hipOccupancyMaxActiveBlocksPerMultiprocessor(&per_cu, (const void*)mega_fwd, NTHREADS, LDS_BYTES);
        if (per_cu < 1) fprintf(stderr, "kernel_launch: occupancy query says %d blocks/CU\n", per_cu);
        (void)hipGetLastError();
        g_grid = cus;
    }
    const float* nsa_qn = (const float*)d_in[3]; const float* nsa_kn = (const float*)d_in[4];
    const float* w2_k = (const float*)d_in[7]; const float* w2_v = (const float*)d_in[10];
    const float* dil_qn = (const float*)d_in[11]; const float* dil_kn = (const float*)d_in[12];
    const float* norm2_g = (const float*)d_in[16]; const float* subkeys = (const float*)d_in[18];
    unsigned char* ws = (unsigned char*)d_ws; float* out = (float*)d_out;
    bf16_t* WTC1K = (bf16_t*)(ws + WS_WTC1K); bf16_t* WTC1V = (bf16_t*)(ws + WS_WTC1V);
    float* ROPE = (float*)(ws + WS_ROPE); float* BIAS1 = (float*)(ws + WS_BIAS1); bf16_t* KCMP = (bf16_t*)(ws + WS_KCMP); bf16_t* VCMP = (bf16_t*)(ws + WS_VCMP);
    bf16_t* HID = (bf16_t*)(ws + WS_HID); float* GATES = (float*)(ws + WS_GATES);
    bf16_t* Y = (bf16_t*)(ws + WS_Y); bf16_t* HN = (bf16_t*)(ws + WS_HN);
    bf16_t* QN = (bf16_t*)(ws + WS_QN); bf16_t* KV6 = (bf16_t*)(ws + WS_KV6); bf16_t* DIL = (bf16_t*)(ws + WS_DIL);
    bf16_t* PQ = (bf16_t*)(ws + WS_PQ); int* IDX = (int*)(ws + WS_IDX); float* GS = (float*)(ws + WS_GS);
    Args a{};
    for (int i = 0; i < 21; ++i) a.in[i] = (const float*)d_in[i];
    a.out = out; a.ws = ws; a.dup = DUP_MASK;

    launch_mega(a, 0, NPH, stream);
}
```

```cpp
#include <hip/hip_runtime.h>
#include <hip/hip_cooperative_groups.h>
#include <cstdio>
#include <cstdint>
namespace cg = cooperative_groups;

typedef unsigned short bf16_t;
typedef short bf16x8 __attribute__((ext_vector_type(8)));
typedef float f32x4 __attribute__((ext_vector_type(4)));
typedef float f32x16 __attribute__((ext_vector_type(16)));
typedef unsigned u32x4 __attribute__((ext_vector_type(4)));
typedef unsigned u32x2 __attribute__((ext_vector_type(2)));
#define LAS __attribute__((address_space(3)))

constexpr int B_ = 8, S_ = 4096, D_ = 1024, T_ = B_ * S_;
constexpr int HD = 64;
constexpr int IN_COLS = 5656, NIN = 5632;
constexpr int NCMP = 255;
constexpr float C2 = 0.125f * 1.4426950408889634f;
constexpr float EPS = 1e-6f;
constexpr int YP = 768;

constexpr size_t MiB = 1u << 20;
constexpr size_t WS_CTL = 0;
constexpr size_t WS_WTIN = 1 * MiB;
constexpr size_t WS_WTCAT = 12 * MiB;
constexpr size_t WS_WTO = 14 * MiB;
constexpr size_t WS_WTQ = 16 * MiB;
constexpr size_t WS_WTC1K = 18 * MiB;
constexpr size_t WS_WTC1V = 19 * MiB;
constexpr size_t WS_MISC = 20 * MiB;
constexpr size_t WS_ROPE = WS_MISC;
constexpr size_t WS_BIAS1 = WS_MISC + 256 * 1024;
constexpr size_t WS_W2T = WS_MISC + 384 * 1024;
constexpr size_t WS_KCMP = WS_MISC + 512 * 1024;
constexpr size_t WS_VCMP = WS_MISC + 1024 * 1024;
constexpr size_t WS_SUBK = WS_MISC + 1536 * 1024;
constexpr size_t WS_WG = WS_MISC + 1600 * 1024;
constexpr size_t WS_GAINS = WS_MISC + 1700 * 1024;
constexpr size_t WS_HID = 22 * MiB;
constexpr size_t WS_GATES = 26 * MiB;
constexpr size_t WS_DLSE = 29 * MiB;
constexpr size_t WS_U = 32 * MiB;
constexpr size_t WS_H = 96 * MiB;
constexpr size_t WS_Y = WS_H;
constexpr size_t WS_HN = WS_H;
constexpr size_t WS_SSQ = 26 * MiB;
constexpr size_t WS_QN = 160 * MiB;
constexpr size_t WS_KV6 = 192 * MiB;
constexpr size_t WS_DIL = 241 * MiB;
constexpr size_t WS_DILO = 385 * MiB;
constexpr size_t WS_MERGED = WS_QN;
constexpr size_t WS_PQ = WS_DIL;
constexpr size_t WS_IDX = WS_DIL + 64 * MiB;
constexpr size_t WS_GS = WS_DIL + 80 * MiB;
constexpr size_t WS_END = 433 * MiB;
constexpr size_t KV6_STRIDE = (size_t)B_ * 2 * S_ * HD;
constexpr size_t DIL_STRIDE = (size_t)B_ * 4 * S_ * HD;

__device__ __forceinline__ float bf2f(bf16_t v) { return __uint_as_float(((unsigned)v) << 16); }
__device__ __forceinline__ bf16_t f2bf(float f) { unsigned u = __float_as_uint(f); return (bf16_t)((u + 0x7fffu + ((u >> 16) & 1u)) >> 16); }
__device__ __forceinline__ unsigned pk2(float lo, float hi) { return (unsigned)f2bf(lo) | ((unsigned)f2bf(hi) << 16); }
__device__ __forceinline__ float wave_sum(float v) {
#pragma unroll
    for (int o = 1; o < 64; o <<= 1) v += __shfl_xor(v, o);
    return v;
}
__device__ __forceinline__ float wave_max(float v) {
#pragma unroll
    for (int o = 1; o < 64; o <<= 1) v = fmaxf(v, __shfl_xor(v, o));
    return v;
}
__device__ __forceinline__ float gelu_tanh(float x) {
    const float u = 0.7978845608028654f * (x + 0.044715f * x * x * x);
    const float e = __expf(2.f * u);
    const float th = 1.f - 2.f / (e + 1.f);
    return 0.5f * x * (1.f + th);
}
__device__ __forceinline__ float sigmoidf_(float x) { return 1.f / (1.f + __expf(-x)); }

__device__ __forceinline__ void wave_gemm64(const bf16_t* __restrict__ A, size_t lda, const bf16_t* __restrict__ Bt, size_t ldb, int K, f32x4 (&acc)[4][4], int lane) {
    const int fr = lane & 15, fq = lane >> 4;
    const bf16_t* ap = A + (size_t)fr * lda + fq * 8; const bf16_t* bp = Bt + (size_t)fr * ldb + fq * 8;
    for (int k = 0; k < K; k += 128) {
        bf16x8 a[4][4], b[4][4];
#pragma unroll
        for (int kk = 0; kk < 4; ++kk)
#pragma unroll
            for (int i = 0; i < 4; ++i) { a[kk][i] = *(const bf16x8*)(ap + (size_t)(16 * i) * lda + k + 32 * kk); b[kk][i] = *(const bf16x8*)(bp + (size_t)(16 * i) * ldb + k + 32 * kk); }
#pragma unroll
        for (int kk = 0; kk < 4; ++kk)
#pragma unroll
            for (int mi = 0; mi < 4; ++mi)
#pragma unroll
                for (int ni = 0; ni < 4; ++ni) acc[mi][ni] = __builtin_amdgcn_mfma_f32_16x16x32_bf16(a[kk][mi], b[kk][ni], acc[mi][ni], 0, 0, 0);
    }
}
#define ZERO_ACC(acc) _Pragma("unroll") for (int _a = 0; _a < 4; ++_a) _Pragma("unroll") for (int _b = 0; _b < 4; ++_b) acc[_a][_b] = (f32x4){0.f, 0.f, 0.f, 0.f}
#define FOR_ACC(acc, r0, c0, lane, ...) _Pragma("unroll") for (int _mi = 0; _mi < 4; ++_mi) _Pragma("unroll") for (int _ni = 0; _ni < 4; ++_ni) _Pragma("unroll") for (int _j = 0; _j < 4; ++_j) { \
    const int row = (r0) + 16 * _mi + 4 * ((lane) >> 4) + _j, col = (c0) + 16 * _ni + ((lane) & 15); const float val = acc[_mi][_ni][_j]; __VA_ARGS__ }

namespace pg8 {
#define PG8_LAS __attribute__((address_space(3)))
typedef unsigned short bf16_t;
typedef short bf16x8 __attribute__((ext_vector_type(8)));
typedef float f32x4 __attribute__((ext_vector_type(4)));
typedef unsigned u32x4 __attribute__((ext_vector_type(4)));
constexpr int BM = 256, BK = 64, HALF = 128, HTB = HALF * BK * 2  , STAGE_BYTES = 8 * HTB, NXCD = 8, WGM = 8;

__host__ __device__ __forceinline__ int lds_byte(int r, int c) { const int st = (r >> 4) * 2 + (c >> 5), rr = r & 15, cc = c & 31, ob = rr * 64 + cc * 2; return st * 1024 + (ob ^ (((ob >> 9) & 1) << 5)); }
__host__ __device__ __forceinline__ void stage_rc(int b, int& R, int& C) { const int st = b / 1024, sb = b % 1024, swz = sb ^ (((sb >> 9) & 1) << 5); R = (st >> 1) * 16 + swz / 64; C = (st & 1) * 32 + (swz % 64) / 2; }
__host__ __device__ __forceinline__ int perm32(int rho) { const int n = rho >> 4, i = rho & 15; return 8 * (i >> 2) + 4 * n + (i & 3); }

struct Unit { int pm, pn; };
struct Gemm { const bf16_t* A; const bf16_t* Bt; int M, N, K; };

struct StaticOrder {
    int nM, nN, nwg, G, c;
    __host__ __device__ void init(int M, int N, int G_, int c_) { nM = M / BM; nN = N / BM; nwg = nM * nN; G = G_; c = c_; }
    __host__ __device__ bool next(int i, Unit& u) const {
        const long L = (long)i * G + c; if (L >= nwg) return false;
        int wgid = (int)L; { const int q = nwg / NXCD, r = nwg % NXCD, xcd = wgid % NXCD, off = wgid / NXCD; wgid = (xcd < r ? xcd * (q + 1) : r * (q + 1) + (xcd - r) * q) + off; }
        const int nig = WGM * nN, gid = wgid / nig, fm = gid * WGM, gsz = (nM - fm) < WGM ? (nM - fm) : WGM;
        u.pm = fm + ((wgid % nig) % gsz); u.pn = (wgid % nig) / gsz; return true;
    }
    __device__ __forceinline__ void a_ready(const Unit&) const {}
    __device__ __forceinline__ void done(const Unit&) const {}
};

__device__ __forceinline__ unsigned cvt_pk_bf16(float lo, float hi) { unsigned r; asm volatile("v_cvt_pk_bf16_f32 %0, %1, %2" : "=v"(r) : "v"(lo), "v"(hi)); return r; }
__device__ __forceinline__ u32x4 pack8(const f32x4 v0, const f32x4 v1) { u32x4 w; w.x = cvt_pk_bf16(v0[0], v0[1]); w.y = cvt_pk_bf16(v0[2], v0[3]); w.z = cvt_pk_bf16(v1[0], v1[1]); w.w = cvt_pk_bf16(v1[2], v1[3]); return w; }
__device__ __forceinline__ float bfl(unsigned w) { return __uint_as_float(w << 16); }
__device__ __forceinline__ float bfh(unsigned w) { return __uint_as_float(w & 0xffff0000u); }
__device__ __forceinline__ float sigm(float x) { return __builtin_amdgcn_rcpf(1.f + __builtin_amdgcn_exp2f(-1.4426950408889634f * x)); }

struct EpiInproj {
    static constexpr bool PERM = true, AFTER_DRAIN = false, HAS_MID = false;
    unsigned char* ws; bf16_t* MG; int mid_t; PG8_LAS float* X;
    __device__ __forceinline__ void mid(f32x4 (&)[2][2][4][2], const Unit&, int, int, int, int) const {}
    __device__ __forceinline__ void operator()(const f32x4 (&acc)[2][2][4][2], const Unit& u, int wr, int wc, int fr, int fq) const {
        asm volatile("" : "+v"(fr), "+v"(fq));
        const int pn = u.pn;
        bf16_t* const QN = (bf16_t*)(ws + WS_QN); bf16_t* const KV6 = (bf16_t*)(ws + WS_KV6); bf16_t* const DIL = (bf16_t*)(ws + WS_DIL);
        const float* const gains = (const float*)(ws + WS_GAINS); const float* const nsa_qn = gains; const float* const nsa_kn = gains + 64; const float* const dil_qn = gains + 256; const float* const dil_kn = gains + 448;
        const float* const rope = (const float*)(ws + WS_ROPE);
        bool nb0 = false, nb1 = false, sg = false; const float* gain = nsa_qn; float scale = 1.f;
        bf16_t* base0; bf16_t* base1; unsigned bstr, rstr; const unsigned dl = (unsigned)((wc & 1) * 32 + fq * 8); unsigned lane_off;
        if (pn < 2) { nb0 = nb1 = true; scale = C2; base0 = QN + pn * 256; base1 = base0 + HALF; bstr = 4096u * 512u; rstr = 512u; lane_off = (unsigned)(wc * 32 + fq * 8); }
        else if (pn < 5) { if (pn == 3) { nb0 = true; gain = nsa_kn + 64; } else if (pn == 4) { nb0 = true; gain = nsa_kn + 128; }
            base0 = KV6 + (size_t)((pn - 2) * 2) * KV6_STRIDE; base1 = base0 + KV6_STRIDE; bstr = 2u * S_ * HD; rstr = HD; lane_off = (unsigned)(wc >> 1) * (unsigned)(S_ * HD) + dl; }
        else if (pn < 14) { const int gw = pn - 5, g = gw / 3, which = gw - 3 * g; if (which == 0) { nb0 = nb1 = true; gain = dil_qn + g * 64; scale = C2; } else if (which == 1) { nb0 = nb1 = true; gain = dil_kn + g * 64; }
            base0 = DIL + (size_t)gw * DIL_STRIDE; base1 = base0 + (size_t)2 * S_ * HD; bstr = 4u * S_ * HD; rstr = HD; lane_off = (unsigned)(wc >> 1) * (unsigned)(S_ * HD) + dl; }
        else { sg = true; base0 = MG + (pn - 14) * 256; base1 = base0 + HALF; bstr = 4096u * 2048u; rstr = 2048u; lane_off = (unsigned)(wc * 32 + fq * 8); }
        const bool anyn = nb0;
        if (anyn) {
#pragma unroll
            for (int ai = 0; ai < 2; ++ai)
#pragma unroll
                for (int m = 0; m < 4; ++m) { const int rl = ai * HALF + wr * 64 + m * 16 + fr;
#pragma unroll
                    for (int bj = 0; bj < 2; ++bj) { if (bj == 1 && !nb1) continue;
                        const f32x4 v0 = acc[ai][bj][m][0], v1 = acc[ai][bj][m][1];
                        float ss = (v0[0] * v0[0] + v0[1] * v0[1]) + (v0[2] * v0[2] + v0[3] * v0[3]) + (v1[0] * v1[0] + v1[1] * v1[1]) + (v1[2] * v1[2] + v1[3] * v1[3]);
                        ss += __shfl_xor(ss, 16); ss += __shfl_xor(ss, 32);
                        if (fq == 0) X[rl * 8 + bj * 4 + wc] = ss; } }
            asm volatile("s_waitcnt lgkmcnt(0)" ::: "memory"); __builtin_amdgcn_s_barrier(); asm volatile("" ::: "memory");
        }
        f32x4 g0 = {1.f, 1.f, 1.f, 1.f}, g1 = g0;
        if (anyn) { g0 = *(const f32x4*)(gain + dl) * scale; g1 = *(const f32x4*)(gain + dl + 4) * scale; }
        const bool ropew = anyn && ((wc & 1) == 0);
#pragma unroll
        for (int ai = 0; ai < 2; ++ai)
#pragma unroll
            for (int m = 0; m < 4; ++m) {
                const int rl = ai * HALF + wr * 64 + m * 16 + fr; const unsigned row = (unsigned)(u.pm * BM + rl); const unsigned s = row & 4095u;
                const unsigned off = (row >> 12) * bstr + s * rstr + lane_off;
                f32x4 c0 = {1.f, 1.f, 1.f, 1.f}, c1 = c0, s0 = {0.f, 0.f, 0.f, 0.f}, s1 = s0;
                if (ropew && fq < 2) { const float* rp = rope + s * 16; c0 = *(const f32x4*)rp; c1 = *(const f32x4*)(rp + 4); s0 = *(const f32x4*)(rp + 8); s1 = *(const f32x4*)(rp + 12); if (fq == 0) { s0 = -s0; s1 = -s1; } }
#pragma unroll
                for (int bj = 0; bj < 2; ++bj) {
                    f32x4 v0 = acc[ai][bj][m][0], v1 = acc[ai][bj][m][1];
                    const bool nrm = (bj == 0) ? nb0 : nb1;
                    if (nrm) {
                        const float tot = X[rl * 8 + bj * 4 + wc] + X[rl * 8 + bj * 4 + (wc ^ 1)];
                        const float rstd = __builtin_amdgcn_rsqf(tot * (1.f / 64.f) + EPS);
                        v0 = v0 * rstd * g0; v1 = v1 * rstd * g1;
                        if (ropew) {
#pragma unroll
                            for (int i = 0; i < 4; ++i) { const float p0 = __shfl_xor(v0[i], 16), p1 = __shfl_xor(v1[i], 16); v0[i] = v0[i] * c0[i] + p0 * s0[i]; v1[i] = v1[i] * c1[i] + p1 * s1[i]; }
                        }
                    }
                    if (sg) {
#pragma unroll
                        for (int i = 0; i < 4; ++i) { v0[i] = sigm(v0[i]); v1[i] = sigm(v1[i]); } }
                    *(u32x4*)((bj ? base1 : base0) + off) = pack8(v0, v1);
                }
                asm volatile("" ::: "memory");
            }
    }
};
struct EpiMerge {
    static constexpr bool PERM = true, AFTER_DRAIN = false, HAS_MID = true;
    const bf16_t* MG; bf16_t* MERGED; int mid_t;
    __device__ __forceinline__ void mid(f32x4 (&acc)[2][2][4][2], const Unit& u, int wr, int wc, int fr, int fq) const {
#pragma unroll
        for (int ai = 0; ai < 2; ++ai)
#pragma unroll
            for (int m = 0; m < 4; ++m) {
                const int row = u.pm * BM + ai * HALF + wr * 64 + m * 16 + fr;
#pragma unroll
                for (int bj = 0; bj < 2; ++bj) {
                    const int col = u.pn * BM + bj * HALF + wc * 32 + fq * 8;
                    const u32x4 a = *(const u32x4*)(MG + (size_t)row * 2048 + col), b = *(const u32x4*)(MG + (size_t)row * 2048 + 1024 + col);
#pragma unroll
                    for (int i = 0; i < 4; ++i) {
                        const float r0 = bfl(a[i]) * __builtin_amdgcn_rcpf(fmaxf(bfl(b[i]), 1e-30f)), r1 = bfh(a[i]) * __builtin_amdgcn_rcpf(fmaxf(bfh(b[i]), 1e-30f));
                        if (i < 2) { acc[ai][bj][m][0][2 * i] *= r0; acc[ai][bj][m][0][2 * i + 1] *= r1; } else { acc[ai][bj][m][1][2 * i - 4] *= r0; acc[ai][bj][m][1][2 * i - 3] *= r1; } }
                }
            }
    }
    __device__ __forceinline__ void operator()(const f32x4 (&acc)[2][2][4][2], const Unit& u, int wr, int wc, int fr, int fq) const {
#pragma unroll
        for (int ai = 0; ai < 2; ++ai)
#pragma unroll
            for (int m = 0; m < 4; ++m) {
                const int row = u.pm * BM + ai * HALF + wr * 64 + m * 16 + fr;
#pragma unroll
                for (int bj = 0; bj < 2; ++bj) {
                    const int col = u.pn * BM + bj * HALF + wc * 32 + fq * 8;
                    const u32x4 b = *(const u32x4*)(MG + (size_t)row * 2048 + 1024 + col);
                    f32x4 v0 = acc[ai][bj][m][0], v1 = acc[ai][bj][m][1];
                    v0[0] *= fmaxf(bfl(b[0]), 1e-30f); v0[1] *= fmaxf(bfh(b[0]), 1e-30f); v0[2] *= fmaxf(bfl(b[1]), 1e-30f); v0[3] *= fmaxf(bfh(b[1]), 1e-30f);
                    v1[0] *= fmaxf(bfl(b[2]), 1e-30f); v1[1] *= fmaxf(bfh(b[2]), 1e-30f); v1[2] *= fmaxf(bfl(b[3]), 1e-30f); v1[3] *= fmaxf(bfh(b[3]), 1e-30f);
                    *(u32x4*)(MERGED + (size_t)row * 1024 + col) = pack8(v0, v1);
                }
            }
    }
};
struct EpiWo {
    static constexpr bool PERM = false, AFTER_DRAIN = false, HAS_MID = false;
    const float* x; float* out; int mid_t; bf16_t* X1B; float* SSQ;
    __device__ __forceinline__ void mid(f32x4 (&)[2][2][4][2], const Unit&, int, int, int, int) const {}
    __device__ __forceinline__ void operator()(const f32x4 (&acc)[2][2][4][2], const Unit& u, int wr, int wc, int fr, int fq) const {
        asm volatile("" : "+v"(fr), "+v"(fq));
#pragma unroll
        for (int ai = 0; ai < 2; ++ai)
#pragma unroll
            for (int m = 0; m < 4; ++m) {
                const int row = u.pm * BM + ai * HALF + wr * 64 + m * 16 + fr;
                const size_t off = (size_t)row * 1024 + u.pn * BM + wc * 32 + fq * 4;
                float ss = 0.f;
#pragma unroll
                for (int bj = 0; bj < 2; ++bj)
#pragma unroll
                    for (int n = 0; n < 2; ++n) { const f32x4 bs = *(const f32x4*)(x + off + bj * HALF + n * 16); const f32x4 v = bs + acc[ai][bj][m][n];
                        ss += (v[0] * v[0] + v[1] * v[1]) + (v[2] * v[2] + v[3] * v[3]);
                        u32x2 w; w.x = cvt_pk_bf16(v[0], v[1]); w.y = cvt_pk_bf16(v[2], v[3]); *(u32x2*)(X1B + off + bj * HALF + n * 16) = w; }
                ss += __shfl_xor(ss, 16); ss += __shfl_xor(ss, 32);
                if (fq == 0) SSQ[(size_t)row * 16 + u.pn * 4 + wc] = ss;
                asm volatile("" ::: "memory");
            }
    }
};
struct EpiPQ {
    static constexpr bool PERM = true, AFTER_DRAIN = false, HAS_MID = false;
    bf16_t* O; const float* SSQ; int mid_t;
    __device__ __forceinline__ void mid(f32x4 (&)[2][2][4][2], const Unit&, int, int, int, int) const {}
    __device__ __forceinline__ void operator()(const f32x4 (&acc)[2][2][4][2], const Unit& u, int wr, int wc, int fr, int fq) const {
        asm volatile("" : "+v"(fr), "+v"(fq));
#pragma unroll
        for (int ai = 0; ai < 2; ++ai)
#pragma unroll
            for (int m = 0; m < 4; ++m) {
                const int row = u.pm * BM + ai * HALF + wr * 64 + m * 16 + fr;
                const f32x4* sp = (const f32x4*)(SSQ + (size_t)row * 16); const f32x4 s4 = (sp[0] + sp[1]) + (sp[2] + sp[3]);
                const float rstd = __builtin_amdgcn_rsqf(((s4[0] + s4[1]) + (s4[2] + s4[3])) * (1.f / 1024.f) + EPS);
                bf16_t* rowp = O + (size_t)row * 1024 + u.pn * BM + wc * 32 + fq * 8;
#pragma unroll
                for (int bj = 0; bj < 2; ++bj) *(u32x4*)(rowp + bj * HALF) = pack8(acc[ai][bj][m][0] * rstd, acc[ai][bj][m][1] * rstd);
                asm volatile("" ::: "memory");
            }
    }
};
struct EpiPlain {
    static constexpr bool PERM = true, AFTER_DRAIN = false, HAS_MID = false;
    bf16_t* O; int ldc; int mid_t;
    __device__ __forceinline__ void mid(f32x4 (&)[2][2][4][2], const Unit&, int, int, int, int) const {}
    __device__ __forceinline__ void operator()(const f32x4 (&acc)[2][2][4][2], const Unit& u, int wr, int wc, int fr, int fq) const {
#pragma unroll
        for (int ai = 0; ai < 2; ++ai)
#pragma unroll
            for (int m = 0; m < 4; ++m) {
                bf16_t* rowp = O + (size_t)(u.pm * BM + ai * HALF + wr * 64 + m * 16 + fr) * ldc + u.pn * BM + wc * 32 + fq * 8;
#pragma unroll
                for (int bj = 0; bj < 2; ++bj) *(u32x4*)(rowp + bj * HALF) = pack8(acc[ai][bj][m][0], acc[ai][bj][m][1]);
            }
    }
};
template <class Epi, class Sched, bool ALIGN_EPI = false, bool SP2 = false>
__device__ __forceinline__ void gemm_phase(PG8_LAS unsigned char* lds, const Gemm g, const Sched& S, const Epi& E) {
    const int tid = threadIdx.x, wid = __builtin_amdgcn_readfirstlane(tid >> 6), lane = tid & 63, wr = wid >> 2, wc = wid & 3, fr = lane & 15, fq = lane >> 4;
    const int K = g.K, nt = K / BK;
    unsigned voffA[2], voffB[2];
#pragma unroll
    for (int i = 0; i < 2; ++i) { int R, C; stage_rc(tid * 16 + i * 8192, R, C); const int Rb = Epi::PERM ? ((R & ~31) + perm32(R & 31)) : R;
        voffA[i] = (unsigned)(R * K + C) * 2u; voffB[i] = (unsigned)(Rb * K + C) * 2u; }
    const size_t kstep = (size_t)(BK * 2);
    const size_t hstep = (size_t)HALF * K * 2;
    const size_t tstep = 2 * hstep;
    const unsigned ldsw = (unsigned)wid * 1024u;
    const int aoff = lds_byte(wr * 64 + fr, fq * 8), boff = lds_byte(wc * 32 + fr, fq * 8);
#define PG8_SA(b, h) (((b) * 2 + (h)) * HTB)
#define PG8_SB(b, h) ((4 + (b) * 2 + (h)) * HTB)
#define PG8_STAGE(bufoff, gbase, voff) do { _Pragma("unroll") for (int _i = 0; _i < 2; ++_i) \
        __builtin_amdgcn_global_load_lds((const unsigned*)((const char*)(gbase) + (voff)[_i]), (PG8_LAS unsigned*)(lds + (bufoff) + ldsw + _i * 8192), 16, 0, 0); } while (0)
#define PG8_LDA(dst, b, h) do { _Pragma("unroll") for (int m = 0; m < 4; ++m) _Pragma("unroll") for (int k = 0; k < 2; ++k) dst[m][k] = *(const PG8_LAS bf16x8*)(lds + PG8_SA(b, h) + aoff + m * 2048 + k * 1024); } while (0)
#define PG8_LDB(dst, b, h) do { _Pragma("unroll") for (int n = 0; n < 2; ++n) _Pragma("unroll") for (int k = 0; k < 2; ++k) dst[n][k] = *(const PG8_LAS bf16x8*)(lds + PG8_SB(b, h) + boff + n * 2048 + k * 1024); } while (0)
#define PG8_MMA(ai, bj, At, Bt) do { __builtin_amdgcn_s_setprio(1); _Pragma("unroll") for (int m = 0; m < 4; ++m) _Pragma("unroll") for (int n = 0; n < 2; ++n) _Pragma("unroll") for (int k = 0; k < 2; ++k) \
        acc[ai][bj][m][n] = __builtin_amdgcn_mfma_f32_16x16x32_bf16(Bt[n][k], At[m][k], acc[ai][bj][m][n], 0, 0, 0); __builtin_amdgcn_s_setprio(0); } while (0)
#define PG8_WAIT_V(n) asm volatile("s_waitcnt vmcnt(" #n ")" ::: "memory")
#define PG8_WAIT_L(n) asm volatile("s_waitcnt lgkmcnt(" #n ")" ::: "memory")
#define PG8_BAR __builtin_amdgcn_s_barrier()
#define PG8_SCHED __builtin_amdgcn_sched_barrier(0)
    Unit cur, nxt; int ui = 0;
    if (!S.next(0, cur)) return;
    f32x4 acc[2][2][4][2];
#pragma unroll
    for (int a = 0; a < 2; ++a)
#pragma unroll
        for (int b = 0; b < 2; ++b)
#pragma unroll
            for (int m = 0; m < 4; ++m)
#pragma unroll
                for (int n = 0; n < 2; ++n) acc[a][b][m][n] = (f32x4){0.f, 0.f, 0.f, 0.f};
    bf16x8 At[4][2], B0[2][2], B1[2][2];
    const char* cA = (const char*)g.A + (size_t)cur.pm * tstep; const char* cB = (const char*)g.Bt + (size_t)cur.pn * tstep;
    S.a_ready(cur);
    if constexpr (SP2) {
        PG8_STAGE(PG8_SB(0, 0), cB, voffB); PG8_STAGE(PG8_SB(0, 1), cB + hstep, voffB); PG8_STAGE(PG8_SA(0, 0), cA, voffA); PG8_STAGE(PG8_SA(0, 1), cA + hstep, voffA);
        if (wr == 1) PG8_BAR;
        PG8_WAIT_V(2); PG8_BAR;
        PG8_STAGE(PG8_SB(1, 0), cB + kstep, voffB); PG8_STAGE(PG8_SA(1, 0), cA + kstep, voffA); PG8_STAGE(PG8_SB(1, 1), cB + hstep + kstep, voffB);
        PG8_WAIT_V(6); PG8_BAR;
    } else {
        PG8_STAGE(PG8_SB(0, 0), cB, voffB); PG8_STAGE(PG8_SA(0, 0), cA, voffA); PG8_STAGE(PG8_SB(0, 1), cB + hstep, voffB); PG8_STAGE(PG8_SA(0, 1), cA + hstep, voffA);
        if (wr == 1) PG8_BAR;
        PG8_WAIT_V(4); PG8_BAR;
        PG8_STAGE(PG8_SB(1, 0), cB + kstep, voffB); PG8_STAGE(PG8_SA(1, 0), cA + kstep, voffA); PG8_STAGE(PG8_SB(1, 1), cB + hstep + kstep, voffB);
        PG8_WAIT_V(6); PG8_BAR;
    }
    for (;;) {
        const bool has_next = S.next(ui + 1, nxt);
        const char* nA = has_next ? (const char*)g.A + (size_t)nxt.pm * tstep : cA; const char* nB = has_next ? (const char*)g.Bt + (size_t)nxt.pn * tstep : cB;
        for (int t = 0; t < nt; t += 2) {
            if constexpr (Epi::HAS_MID) { if (t == E.mid_t) E.mid(acc, cur, wr, wc, fr, fq); }
            const bool last = (t == nt - 2);
            const char* a1 = cA + (size_t)(t + 1) * kstep;
            const char* a2 = last ? nA : cA + (size_t)(t + 2) * kstep; const char* b2 = last ? nB : cB + (size_t)(t + 2) * kstep;
            const char* a3 = a2 + kstep; const char* b3 = b2 + kstep;
            if (last && has_next) S.a_ready(nxt);
            if constexpr (SP2) {
            PG8_LDB(B0, 0, 0); PG8_LDB(B1, 0, 1); PG8_SCHED; PG8_LDA(At, 0, 0); PG8_STAGE(PG8_SA(1, 1), a1 + hstep, voffA);
            PG8_WAIT_V(8); PG8_WAIT_L(0); PG8_BAR; PG8_MMA(0, 0, At, B0); PG8_MMA(0, 1, At, B1); PG8_BAR; PG8_SCHED;
            PG8_LDA(At, 0, 1); PG8_STAGE(PG8_SB(0, 0), b2, voffB); PG8_STAGE(PG8_SB(0, 1), b2 + hstep, voffB); PG8_STAGE(PG8_SA(0, 0), a2, voffA);
            PG8_WAIT_V(8); PG8_WAIT_L(0); PG8_BAR; PG8_MMA(1, 0, At, B0); PG8_MMA(1, 1, At, B1); PG8_BAR; PG8_SCHED;
            PG8_LDB(B0, 1, 0); PG8_LDB(B1, 1, 1); PG8_SCHED; PG8_LDA(At, 1, 0); PG8_STAGE(PG8_SA(0, 1), a2 + hstep, voffA);
            PG8_WAIT_V(8); PG8_WAIT_L(0); PG8_BAR; PG8_MMA(0, 0, At, B0); PG8_MMA(0, 1, At, B1); PG8_BAR; PG8_SCHED;
            PG8_LDA(At, 1, 1); PG8_STAGE(PG8_SB(1, 0), b3, voffB); PG8_STAGE(PG8_SB(1, 1), b3 + hstep, voffB); PG8_STAGE(PG8_SA(1, 0), a3, voffA);
            PG8_WAIT_V(8); PG8_WAIT_L(0); PG8_BAR; PG8_MMA(1, 0, At, B0); PG8_MMA(1, 1, At, B1); PG8_BAR; PG8_SCHED;
            } else {
            PG8_LDB(B0, 0, 0); PG8_SCHED; PG8_LDA(At, 0, 0); PG8_STAGE(PG8_SA(1, 1), a1 + hstep, voffA);
            PG8_WAIT_L(8); PG8_BAR; PG8_WAIT_L(0); PG8_MMA(0, 0, At, B0); PG8_BAR; PG8_SCHED;
            PG8_LDB(B1, 0, 1); PG8_STAGE(PG8_SB(0, 0), b2, voffB);
            PG8_BAR; PG8_WAIT_L(0); PG8_MMA(0, 1, At, B1); PG8_BAR;
            PG8_LDA(At, 0, 1); PG8_STAGE(PG8_SA(0, 0), a2, voffA);
            PG8_BAR; PG8_WAIT_L(0); PG8_MMA(1, 0, At, B0); PG8_BAR; PG8_SCHED;
            PG8_STAGE(PG8_SB(0, 1), b2 + hstep, voffB);
            PG8_WAIT_V(6); PG8_BAR; PG8_MMA(1, 1, At, B1); PG8_BAR;
            PG8_LDB(B0, 1, 0); PG8_SCHED; PG8_LDA(At, 1, 0); PG8_STAGE(PG8_SA(0, 1), a2 + hstep, voffA);
            PG8_WAIT_L(8); PG8_BAR; PG8_WAIT_L(0); PG8_MMA(0, 0, At, B0); PG8_BAR; PG8_SCHED;
            PG8_LDB(B1, 1, 1); PG8_STAGE(PG8_SB(1, 0), b3, voffB);
            PG8_BAR; PG8_WAIT_L(0); PG8_MMA(0, 1, At, B1); PG8_BAR;
            PG8_LDA(At, 1, 1); PG8_STAGE(PG8_SA(1, 0), a3, voffA);
            PG8_BAR; PG8_WAIT_L(0); PG8_MMA(1, 0, At, B0); PG8_BAR; PG8_SCHED;
            PG8_STAGE(PG8_SB(1, 1), b3 + hstep, voffB);
            PG8_WAIT_V(6); PG8_BAR; PG8_MMA(1, 1, At, B1); PG8_BAR;
            }
        }
        if constexpr (ALIGN_EPI) { if (wr == 0) PG8_BAR; }
        if constexpr (!Epi::AFTER_DRAIN) { E(acc, cur, wr, wc, fr, fq); S.done(cur); }
        if (!has_next) break;
#pragma unroll
        for (int a = 0; a < 2; ++a)
#pragma unroll
            for (int b = 0; b < 2; ++b)
#pragma unroll
                for (int m = 0; m < 4; ++m)
#pragma unroll
                    for (int n = 0; n < 2; ++n) acc[a][b][m][n] = (f32x4){0.f, 0.f, 0.f, 0.f};
        cur = nxt; cA = nA; cB = nB; ++ui;
        if constexpr (ALIGN_EPI) { if (wr == 1) PG8_BAR; }
    }
    PG8_WAIT_V(0);
    if constexpr (!ALIGN_EPI) { if (wr == 0) PG8_BAR; }
    PG8_BAR;
    if constexpr (Epi::AFTER_DRAIN) { E.fused(acc, cur, wr, wc, fr, fq, lds, wid, lane); S.done(cur); }
#undef PG8_SA
#undef PG8_SB
#undef PG8_STAGE
#undef PG8_LDA
#undef PG8_LDB
#undef PG8_MMA
#undef PG8_WAIT_V
#undef PG8_WAIT_L
#undef PG8_BAR
#undef PG8_SCHED
}
}
namespace att {
typedef short s16x4 __attribute__((ext_vector_type(4)));
__device__ __forceinline__ int crow(int r, int hi) { return (r & 3) + 8 * (r >> 2) + 4 * hi; }
__device__ __forceinline__ float max3f(float a, float b, float c) { float r; asm("v_max3_f32 %0, %1, %2, %3" : "=v"(r) : "v"(a), "v"(b), "v"(c)); return r; }
typedef float f32x2_t __attribute__((ext_vector_type(2))); typedef __bf16 bf16x2_t __attribute__((ext_vector_type(2)));
__device__ __forceinline__ unsigned cvtpk(float lo, float hi) { f32x2_t v = {lo, hi}; bf16x2_t b = __builtin_convertvector(v, bf16x2_t); return __builtin_bit_cast(unsigned, b); }
__device__ __forceinline__ float ex2(float v) { return __builtin_amdgcn_exp2f(v); }
__device__ __forceinline__ float swap_add(float v) { auto rr = __builtin_amdgcn_permlane32_swap(__float_as_uint(v), __float_as_uint(v), false, false); return __uint_as_float(rr[0]) + __uint_as_float(rr[1]); }
__device__ __forceinline__ float swap_max(float v) { auto rr = __builtin_amdgcn_permlane32_swap(__float_as_uint(v), __float_as_uint(v), false, false); return fmaxf(__uint_as_float(rr[0]), __uint_as_float(rr[1])); }

__device__ __forceinline__ void dma_k(const bf16_t* Kt, size_t pitch, LAS unsigned char* kslot, int wid, int lane) {
    __builtin_amdgcn_global_load_lds((const unsigned*)(Kt + (size_t)lane * pitch + wid * 8), (LAS unsigned*)(kslot + wid * 1024), 16, 0, 0);
}
__device__ __forceinline__ void dma_v(const bf16_t* Vt, size_t pitch, LAS unsigned char* vslot, int wid, int lane) {
    __builtin_amdgcn_global_load_lds((const unsigned*)(Vt + (size_t)(16 * (wid & 3) + (lane >> 2)) * pitch + (wid >> 2) * 32 + (lane & 3) * 8), (LAS unsigned*)(vslot + wid * 1024), 16, 0, 0);
}
template <bool BIAS>
__device__ __forceinline__ void qkt(f32x16& p0, f32x16& p1, const LAS unsigned char* kslot, const bf16x8 (&qr)[4], float bias, int r32, int hi) {
    const LAS unsigned char* kb = kslot + hi * 1024 + r32 * 16;
    f32x16 c0;
#pragma unroll
    for (int i = 0; i < 16; ++i) c0[i] = BIAS ? bias : 0.f;
#pragma unroll
    for (int d0 = 0; d0 < 4; ++d0) {
        const bf16x8 b0 = *(const LAS bf16x8*)(kb + d0 * 2048), b1 = *(const LAS bf16x8*)(kb + d0 * 2048 + 512);
        if (d0 == 0) { p0 = __builtin_amdgcn_mfma_f32_32x32x16_bf16(b0, qr[0], c0, 0, 0, 0); p1 = __builtin_amdgcn_mfma_f32_32x32x16_bf16(b1, qr[0], c0, 0, 0, 0); }
        else { p0 = __builtin_amdgcn_mfma_f32_32x32x16_bf16(b0, qr[d0], p0, 0, 0, 0); p1 = __builtin_amdgcn_mfma_f32_32x32x16_bf16(b1, qr[d0], p1, 0, 0, 0); }
    }
    asm volatile("s_nop 15\n\ts_nop 7" : "+v"(p0), "+v"(p1));
}
template <int K> __device__ __forceinline__ float keep_le(float p, int lim, float alt) { float r; asm volatile("v_cmp_le_i32 vcc, %1, %2\n\tv_cndmask_b32 %0, %3, %4, vcc" : "=v"(r) : "n"(K), "v"(lim), "v"(alt), "v"(p) : "vcc"); return r; }
__device__ __forceinline__ void mask_le(f32x16& p0, f32x16& p1, int lim, int hi, float alt) {
    const int l0 = lim - 4 * hi;
#define ATT_M(r) p0[r] = keep_le<((r) & 3) + 8 * ((r) >> 2)>(p0[r], l0, alt); p1[r] = keep_le<((r) & 3) + 8 * ((r) >> 2) + 32>(p1[r], l0, alt);
    ATT_M(0) ATT_M(1) ATT_M(2) ATT_M(3) ATT_M(4) ATT_M(5) ATT_M(6) ATT_M(7) ATT_M(8) ATT_M(9) ATT_M(10) ATT_M(11) ATT_M(12) ATT_M(13) ATT_M(14) ATT_M(15)
#undef ATT_M
}
template <int K> __device__ __forceinline__ float keep_gt(float p, int lim, float alt) { float r; asm volatile("v_cmp_gt_i32 vcc, %1, %2\n\tv_cndmask_b32 %0, %3, %4, vcc" : "=v"(r) : "n"(K), "v"(lim), "v"(alt), "v"(p) : "vcc"); return r; }
__device__ __forceinline__ void mask_gt(f32x16& p0, f32x16& p1, int lim, int hi, float alt) {
    const int l0 = lim - 4 * hi;
#define ATT_M(r) p0[r] = keep_gt<((r) & 3) + 8 * ((r) >> 2)>(p0[r], l0, alt); p1[r] = keep_gt<((r) & 3) + 8 * ((r) >> 2) + 32>(p1[r], l0, alt);
    ATT_M(0) ATT_M(1) ATT_M(2) ATT_M(3) ATT_M(4) ATT_M(5) ATT_M(6) ATT_M(7) ATT_M(8) ATT_M(9) ATT_M(10) ATT_M(11) ATT_M(12) ATT_M(13) ATT_M(14) ATT_M(15)
#undef ATT_M
}
__device__ __forceinline__ float rowmax(const f32x16& p0, const f32x16& p1) {
    float a = max3f(p0[0], p0[1], p1[0]), b = max3f(p0[2], p0[3], p1[1]); a = max3f(a, p1[2], p1[3]);
#pragma unroll
    for (int r = 4; r < 16; r += 4) { a = max3f(a, p0[r], p0[r + 1]); b = max3f(b, p0[r + 2], p0[r + 3]); a = max3f(a, p1[r], p1[r + 1]); b = max3f(b, p1[r + 2], p1[r + 3]); }
    return swap_max(fmaxf(a, b));
}
__device__ __forceinline__ float rowsum32(const f32x16& p0, const f32x16& p1) {
    float a = 0.f, b = 0.f;
#pragma unroll
    for (int r = 0; r < 16; r += 2) { a += p0[r] + p1[r]; b += p0[r + 1] + p1[r + 1]; }
    return a + b;
}
template <bool LSUM>
__device__ __forceinline__ void pv(f32x16 (&o)[2], f32x16& lacc, unsigned vb, const f32x16& p0, const f32x16& p1) {
    u32x4 pw0, pw1, pw2, pw3;
    pw0 = (u32x4){cvtpk(p0[0], p0[1]), cvtpk(p0[2], p0[3]), cvtpk(p0[4], p0[5]), cvtpk(p0[6], p0[7])};
    pw1 = (u32x4){cvtpk(p0[8], p0[9]), cvtpk(p0[10], p0[11]), cvtpk(p0[12], p0[13]), cvtpk(p0[14], p0[15])};
    pw2 = (u32x4){cvtpk(p1[0], p1[1]), cvtpk(p1[2], p1[3]), cvtpk(p1[4], p1[5]), cvtpk(p1[6], p1[7])};
    pw3 = (u32x4){cvtpk(p1[8], p1[9]), cvtpk(p1[10], p1[11]), cvtpk(p1[12], p1[13]), cvtpk(p1[14], p1[15])};
    const bf16x8 pa0 = __builtin_bit_cast(bf16x8, pw0), pa1 = __builtin_bit_cast(bf16x8, pw1), pa2 = __builtin_bit_cast(bf16x8, pw2), pa3 = __builtin_bit_cast(bf16x8, pw3);
    if (LSUM) {
        const short one = (short)0x3F80; const bf16x8 ones = {one, one, one, one, one, one, one, one};
        lacc = __builtin_amdgcn_mfma_f32_32x32x16_bf16(pa0, ones, lacc, 0, 0, 0); lacc = __builtin_amdgcn_mfma_f32_32x32x16_bf16(pa1, ones, lacc, 0, 0, 0);
        lacc = __builtin_amdgcn_mfma_f32_32x32x16_bf16(pa2, ones, lacc, 0, 0, 0); lacc = __builtin_amdgcn_mfma_f32_32x32x16_bf16(pa3, ones, lacc, 0, 0, 0);
    }
#pragma unroll
    for (int d0 = 0; d0 < 2; ++d0) { s16x4 lo[4], hi[4];
#pragma unroll
        for (int ks = 0; ks < 4; ++ks) {
            asm volatile("ds_read_b64_tr_b16 %0,%1 offset:%c2" : "=&v"(lo[ks]) : "v"(vb), "i"(d0 * 4096 + ks * 1024) : "memory");
            asm volatile("ds_read_b64_tr_b16 %0,%1 offset:%c2" : "=&v"(hi[ks]) : "v"(vb), "i"(d0 * 4096 + ks * 1024 + 512) : "memory"); }
        asm volatile("s_waitcnt lgkmcnt(0)" ::: "memory"); __builtin_amdgcn_sched_barrier(0);
#define ATT_PK(k) (bf16x8){lo[k][0], lo[k][1], lo[k][2], lo[k][3], hi[k][0], hi[k][1], hi[k][2], hi[k][3]}
        o[d0] = __builtin_amdgcn_mfma_f32_32x32x16_bf16(pa0, ATT_PK(0), o[d0], 0, 0, 0);
        o[d0] = __builtin_amdgcn_mfma_f32_32x32x16_bf16(pa1, ATT_PK(1), o[d0], 0, 0, 0);
        o[d0] = __builtin_amdgcn_mfma_f32_32x32x16_bf16(pa2, ATT_PK(2), o[d0], 0, 0, 0);
        o[d0] = __builtin_amdgcn_mfma_f32_32x32x16_bf16(pa3, ATT_PK(3), o[d0], 0, 0, 0);
#undef ATT_PK
    }
}
__device__ __forceinline__ void lds_fadd(LAS float* p, float v) { (void)__hip_atomic_fetch_add(p, v, __ATOMIC_RELAXED, __HIP_MEMORY_SCOPE_WORKGROUP); }
__device__ __forceinline__ f32x16 splat16(float v) { f32x16 r;
#pragma unroll
    for (int i = 0; i < 16; ++i) r[i] = v;
    return r; }

struct Soft { float m; f32x16 o[2]; f32x16 lacc; };
__device__ __forceinline__ void soft_init(Soft& s) { s.m = 0.f; s.o[0] = splat16(0.f); s.o[1] = splat16(0.f); s.lacc = splat16(0.f); }
constexpr float SOFT_THR = 8.f;
template <bool FIRST>
__device__ __forceinline__ void soft_step(Soft& s, f32x16& p0, f32x16& p1, LAS float* wsf, int r32, int hi) {
    const float rm = rowmax(p0, p1);
    if (FIRST) {
        s.m = rm;
#pragma unroll
        for (int r = 0; r < 16; ++r) { p0[r] -= rm; p1[r] -= rm; }
    } else if (__any(rm > SOFT_THR)) {
        const float delta = (rm > SOFT_THR) ? rm : 0.f, f = ex2(-delta); s.m += delta;
        if (hi == 0) wsf[r32] = f;
        asm volatile("s_waitcnt lgkmcnt(0)" ::: "memory");
#pragma unroll
        for (int r = 0; r < 16; ++r) { const float fr = wsf[crow(r, hi)]; s.o[0][r] *= fr; s.o[1][r] *= fr; s.lacc[r] *= fr; p0[r] -= delta; p1[r] -= delta; }
        asm volatile("s_waitcnt lgkmcnt(0)" ::: "memory");
    }
#pragma unroll
    for (int r = 0; r < 16; ++r) { p0[r] = ex2(p0[r]); p1[r] = ex2(p1[r]); }
}
#define ATT_SYNC() do { asm volatile("s_waitcnt vmcnt(0) lgkmcnt(0)" ::: "memory"); __syncthreads(); } while (0)
#define ATT_RING_SYNC(N) do { asm volatile("s_waitcnt vmcnt(" #N ") lgkmcnt(0)" ::: "memory"); __builtin_amdgcn_s_barrier(); asm volatile("" ::: "memory"); } while (0)


typedef short v4i16_t __attribute__((ext_vector_type(4)));
__device__ __forceinline__ void kload8(bf16x8 (&kf)[8], const LAS unsigned char* kslot, int r32, int hi) {
    const LAS unsigned char* kb = kslot + hi * 1024 + r32 * 16;
#pragma unroll
    for (int d0 = 0; d0 < 4; ++d0) { kf[2 * d0] = *(const LAS bf16x8*)(kb + d0 * 2048); kf[2 * d0 + 1] = *(const LAS bf16x8*)(kb + d0 * 2048 + 512); }
}
template <bool BIAS>
__device__ __forceinline__ void qkt_reg(f32x16& p0, f32x16& p1, const bf16x8 (&kf)[8], const bf16x8 (&qr)[4], float bias) {
    f32x16 c0;
#pragma unroll
    for (int i = 0; i < 16; ++i) c0[i] = BIAS ? bias : 0.f;
#pragma unroll
    for (int d0 = 0; d0 < 4; ++d0) {
        if (d0 == 0) { p0 = __builtin_amdgcn_mfma_f32_32x32x16_bf16(kf[0], qr[0], c0, 0, 0, 0); p1 = __builtin_amdgcn_mfma_f32_32x32x16_bf16(kf[1], qr[0], c0, 0, 0, 0); }
        else { p0 = __builtin_amdgcn_mfma_f32_32x32x16_bf16(kf[2 * d0], qr[d0], p0, 0, 0, 0); p1 = __builtin_amdgcn_mfma_f32_32x32x16_bf16(kf[2 * d0 + 1], qr[d0], p1, 0, 0, 0); }
    }
    asm volatile("s_nop 15\n\ts_nop 7" : "+v"(p0), "+v"(p1));
}
__device__ __forceinline__ s16x4 vtr(const LAS unsigned char* p) { return __builtin_bit_cast(s16x4, __builtin_amdgcn_ds_read_tr16_b64_v4i16((LAS v4i16_t*)p)); }
__device__ __forceinline__ void vload8(s16x4 (&vf)[8], const LAS unsigned char* vp, int d0) {
#pragma unroll
    for (int ks = 0; ks < 4; ++ks) { vf[2 * ks] = vtr(vp + d0 * 4096 + ks * 1024); vf[2 * ks + 1] = vtr(vp + d0 * 4096 + ks * 1024 + 512); }
}
__device__ __forceinline__ void pv_reg(f32x16 (&o)[2], f32x16& lacc, s16x4 (&vf)[8], const LAS unsigned char* vp, const f32x16& p0, const f32x16& p1) {
    u32x4 pw0, pw1, pw2, pw3;
    pw0 = (u32x4){cvtpk(p0[0], p0[1]), cvtpk(p0[2], p0[3]), cvtpk(p0[4], p0[5]), cvtpk(p0[6], p0[7])};
    pw1 = (u32x4){cvtpk(p0[8], p0[9]), cvtpk(p0[10], p0[11]), cvtpk(p0[12], p0[13]), cvtpk(p0[14], p0[15])};
    pw2 = (u32x4){cvtpk(p1[0], p1[1]), cvtpk(p1[2], p1[3]), cvtpk(p1[4], p1[5]), cvtpk(p1[6], p1[7])};
    pw3 = (u32x4){cvtpk(p1[8], p1[9]), cvtpk(p1[10], p1[11]), cvtpk(p1[12], p1[13]), cvtpk(p1[14], p1[15])};
    const bf16x8 pa[4] = {__builtin_bit_cast(bf16x8, pw0), __builtin_bit_cast(bf16x8, pw1), __builtin_bit_cast(bf16x8, pw2), __builtin_bit_cast(bf16x8, pw3)};
#pragma unroll
    for (int ks = 0; ks < 4; ++ks) { const s16x4 lo = vf[2 * ks], hh = vf[2 * ks + 1]; const bf16x8 vv = {lo[0], lo[1], lo[2], lo[3], hh[0], hh[1], hh[2], hh[3]};
        o[0] = __builtin_amdgcn_mfma_f32_32x32x16_bf16(pa[ks], vv, o[0], 0, 0, 0); }
    __builtin_amdgcn_sched_barrier(0);
    vload8(vf, vp, 1);
    __builtin_amdgcn_sched_barrier(0);
    const short one = (short)0x3F80; const bf16x8 ones = {one, one, one, one, one, one, one, one};
#pragma unroll
    for (int ks = 0; ks < 4; ++ks) lacc = __builtin_amdgcn_mfma_f32_32x32x16_bf16(pa[ks], ones, lacc, 0, 0, 0);
#pragma unroll
    for (int ks = 0; ks < 4; ++ks) { const s16x4 lo = vf[2 * ks], hh = vf[2 * ks + 1]; const bf16x8 vv = {lo[0], lo[1], lo[2], lo[3], hh[0], hh[1], hh[2], hh[3]};
        o[1] = __builtin_amdgcn_mfma_f32_32x32x16_bf16(pa[ks], vv, o[1], 0, 0, 0); }
}
#define ATT_SB() __builtin_amdgcn_sched_barrier(0)

#ifndef NSA_REP_CMP
#define NSA_REP_CMP 1
#endif
#ifndef NSA_REP_SLT
#define NSA_REP_SLT 1
#endif
#ifndef NSA_REP_SEL
#define NSA_REP_SEL 1
#endif
#ifndef NSA_REP_WIN
#define NSA_REP_WIN 1
#endif
constexpr int NSA_LK = 0, NSA_LV = 32768, NSA_IMP = 65536, NSA_WSF = NSA_IMP + 4 * 64 * 65 * 4, NSA_SELM = NSA_WSF + 8 * 256, NSA_SV = NSA_SELM + 512, NSA_END = NSA_SV + 8 * 256;
static_assert(NSA_END <= 147456, "NSA LDS map");
__device__ __forceinline__ void acc_store(LAS float* accp, const f32x16 (&o)[2], const f32x16* lsum, LAS float* wsf, float gate, int r32, int hi, bool add, bf16_t* yb) {
    if (hi == 0) wsf[32 + r32] = gate;
    asm volatile("s_waitcnt lgkmcnt(0)" ::: "memory");
#pragma unroll
    for (int r = 0; r < 16; ++r) { float fr = wsf[32 + crow(r, hi)]; if (lsum) fr *= __builtin_amdgcn_rcpf((*lsum)[r]);
        float v0 = o[0][r] * fr, v1 = o[1][r] * fr;
        if (add) { v0 += accp[r * 64]; v1 += accp[(16 + r) * 64]; }
        if (yb) { const int q = crow(r, hi); yb[(size_t)q * YP] = f2bf(v0); yb[(size_t)q * YP + 32] = f2bf(v1); }
        else { accp[r * 64] = v0; accp[(16 + r) * 64] = v1; } }
    asm volatile("s_waitcnt lgkmcnt(0)" ::: "memory");
}
__device__ __forceinline__ void nsa_unit(LAS unsigned char* lds, int b, int g, int n, const bf16_t* QN, const bf16_t* KV6, const bf16_t* KCMP, const bf16_t* VCMP, const float* gates, bf16_t* Y, int wid, int lane) {
    const int r32 = lane & 31, hi = lane >> 5, j = wid & 3, th = wid >> 2, hh = g * 4 + j;
    const int tokl = 32 * th + r32;
    const int s_tok = 64 * n + tokl;
    const size_t trow = (size_t)b * S_ + s_tok;
    LAS float* wsf = (LAS float*)(lds + NSA_WSF + wid * 256);
    LAS float* imp = (LAS float*)(lds + NSA_IMP);
    LAS float* accp = (LAS float*)(lds + NSA_IMP + wid * 8192) + lane;
    const size_t bg = (size_t)(b * 2 + g);
    const unsigned vb = (unsigned)(uintptr_t)(lds + NSA_LV) + ((lane >> 4) & 1) * 32 + (lane & 3) * 8 + (4 * hi + ((lane & 15) >> 2)) * 64;
    bf16x8 qr[4];
#pragma unroll
    for (int d0 = 0; d0 < 4; ++d0) qr[d0] = *(const bf16x8*)(QN + trow * 512 + hh * 64 + d0 * 16 + hi * 8);
    const float NEGINF = -INFINITY;

    const int ntc = (4 * n + 2) / 64 + 1;
    const int cmax = (s_tok >= 31) ? min((s_tok - 31) >> 4, NCMP - 1) : -1;
    f32x16 oc[2];
    for (int rep_ = 0; rep_ < NSA_REP_CMP; ++rep_) {
    __syncthreads();
    {
        const bf16_t* kc = KCMP + bg * 256 * 64; const bf16_t* vc = VCMP + bg * 256 * 64;
        for (int ti = 0; ti < ntc; ++ti) { dma_k(kc + (size_t)ti * 64 * 64, 64, lds + NSA_LK + ti * 8192, wid, lane); dma_v(vc + (size_t)ti * 64 * 64, 64, lds + NSA_LV + ti * 8192, wid, lane); }
    }
    ATT_SYNC();
    {
        float m = -1e30f, l = 0.f;
        for (int ti = 0; ti < ntc; ++ti) {
            f32x16 p0, p1; qkt<false>(p0, p1, lds + NSA_LK + ti * 8192, qr, 0.f, r32, hi);
            mask_le(p0, p1, cmax - 64 * ti, hi, -1e30f);
            const float rm = rowmax(p0, p1); const float mn = fmaxf(m, rm);
            float sum = 0.f;
#pragma unroll
            for (int r = 0; r < 16; ++r) sum += ex2(p0[r] - mn) + ex2(p1[r] - mn);
            l = l * ex2(m - mn) + swap_add(sum); m = mn;
        }
        const float inv = (s_tok >= 31) ? 1.f / l : 0.f;
        oc[0] = splat16(0.f); oc[1] = splat16(0.f);
        LAS float* impj = imp + (j * 64 + tokl) * 65; float carry = 0.f;
        for (int ti = 0; ti < ntc; ++ti) {
            f32x16 p0, p1; qkt<false>(p0, p1, lds + NSA_LK + ti * 8192, qr, 0.f, r32, hi);
            mask_le(p0, p1, cmax - 64 * ti, hi, -1e30f);
#pragma unroll
            for (int r = 0; r < 16; ++r) { p0[r] = ex2(p0[r] - m) * inv; p1[r] = ex2(p1[r] - m) * inv; }
            {
                float av[8], bv[8];
#pragma unroll
                for (int G4 = 0; G4 < 4; ++G4) { bv[G4] = 0.5f * p0[4 * G4 + 3]; av[G4] = (p0[4 * G4] + p0[4 * G4 + 1]) + (p0[4 * G4 + 2] + bv[G4]); bv[4 + G4] = 0.5f * p1[4 * G4 + 3]; av[4 + G4] = (p1[4 * G4] + p1[4 * G4 + 1]) + (p1[4 * G4 + 2] + bv[4 + G4]); }
                float rv[8];
#pragma unroll
                for (int g8 = 0; g8 < 8; ++g8) { auto rr = __builtin_amdgcn_permlane32_swap(__float_as_uint(bv[g8]), __float_as_uint(bv[g8]), false, false); rv[g8] = __uint_as_float(hi ? rr[0] : rr[1]); }
#pragma unroll
                for (int g8 = 0; g8 < 8; ++g8) { const float inc = hi ? rv[g8] : (g8 ? rv[g8 - 1] : carry); impj[16 * ti + 2 * g8 + hi] = av[g8] + inc; }
                carry = rv[7];
            }
            pv<false>(oc, oc[0], vb + ti * 8192, p0, p1);
        }
    }
    ATT_SYNC();
    }
    const bf16_t* ks = KV6 + 2 * KV6_STRIDE + bg * S_ * HD; const bf16_t* vs = KV6 + 3 * KV6_STRIDE + bg * S_ * HD;
    dma_k(ks + (size_t)n * 64 * 64, 64, lds + NSA_LK, wid, lane); dma_v(vs + (size_t)n * 64 * 64, 64, lds + NSA_LV, wid, lane);
    {
        LAS unsigned long long* selm = (LAS unsigned long long*)(lds + NSA_SELM);
        const bool cand = (lane >= 1) && (lane <= n - 2);
        const unsigned long long candm = __ballot(cand);
        for (int rep_ = 0; rep_ < NSA_REP_SLT; ++rep_)
        for (int i = 0; i < 8; ++i) {
            const int tk = wid * 8 + i;
            const float v = ((imp[(0 * 64 + tk) * 65 + lane] + imp[(1 * 64 + tk) * 65 + lane]) + imp[(2 * 64 + tk) * 65 + lane]) + imp[(3 * 64 + tk) * 65 + lane];
            bool sel;
            if (n < 16) sel = (lane <= n);
            else {
                const unsigned key = __float_as_uint(v);
                unsigned T = 0u;
                for (int bit = 30; bit >= 0; --bit) { const unsigned Tt = T | (1u << bit); const unsigned long long ge = __ballot(key >= Tt) & candm; if (__builtin_popcountll(ge) >= 13) T = Tt; }
                const unsigned long long gtm = __ballot(key > T) & candm, eqm = __ballot(key == T) & candm;
                const int need = 13 - (int)__builtin_popcountll(gtm);
                const int eqrank = (int)__builtin_popcountll(eqm & ((1ull << lane) - 1ull));
                sel = (lane == 0) || (lane == n) || (lane == n - 1) || (cand && (key > T || (key == T && eqrank < need)));
            }
            const unsigned long long bal = __ballot(sel);
            if (lane == 0) selm[tk] = bal;
        }
    }
    ATT_SYNC();
    const unsigned long long myselm = ((LAS unsigned long long*)(lds + NSA_SELM))[tokl];
    acc_store(accp, oc, nullptr, wsf, gates[trow * 24 + hh * 3 + 0], r32, hi, false, nullptr);
    const LAS unsigned char* vpl = lds + NSA_LV + ((lane >> 4) & 1) * 32 + (lane & 3) * 8 + (4 * hi + ((lane & 15) >> 2)) * 64;
    bf16x8 kf[8]; s16x4 vf[8];
    {
        Soft ss;
        for (int rep_ = 0; rep_ < NSA_REP_SEL; ++rep_) {
        if (rep_) { ATT_SYNC(); dma_k(ks + (size_t)n * 64 * 64, 64, lds + NSA_LK, wid, lane); dma_v(vs + (size_t)n * 64 * 64, 64, lds + NSA_LV, wid, lane); ATT_SYNC(); }
        soft_init(ss);
        const int nt = n + 1;
        if (nt > 1) { dma_k(ks, 64, lds + NSA_LK + 8192, wid, lane); dma_v(vs, 64, lds + NSA_LV + 8192, wid, lane); }
        kload8(kf, lds + NSA_LK, r32, hi);
        int slot = 0;
        for (int i = 0; i < nt; ++i) {
            const int np = (i == 0) ? n : i - 1;
            const bool bit = (myselm >> np) & 1ull;
            f32x16 p0, p1;
            if (i == 0) qkt_reg<false>(p0, p1, kf, qr, 0.f); else qkt_reg<true>(p0, p1, kf, qr, bit ? -ss.m : NEGINF);
            ATT_SB(); vload8(vf, vpl + slot * 8192, 0); ATT_SB();
            if (i == 0) { mask_le(p0, p1, tokl, hi, NEGINF); soft_step<true>(ss, p0, p1, wsf, r32, hi); } else soft_step<false>(ss, p0, p1, wsf, r32, hi);
            const int s1 = (slot == 2) ? 0 : slot + 1;
            if (i + 1 < nt) {
                ATT_SB(); asm volatile("s_waitcnt vmcnt(0)" ::: "memory"); __builtin_amdgcn_s_barrier(); asm volatile("" ::: "memory");
                if (i + 2 < nt) { const int s2 = (slot == 0) ? 2 : slot - 1; dma_k(ks + (size_t)(i + 1) * 64 * 64, 64, lds + NSA_LK + s2 * 8192, wid, lane); dma_v(vs + (size_t)(i + 1) * 64 * 64, 64, lds + NSA_LV + s2 * 8192, wid, lane); }
                kload8(kf, lds + NSA_LK + s1 * 8192, r32, hi); ATT_SB();
            }
            pv_reg(ss.o, ss.lacc, vf, vpl + slot * 8192, p0, p1);
            slot = s1;
        }
        }
        acc_store(accp, ss.o, &ss.lacc, wsf, gates[trow * 24 + hh * 3 + 1], r32, hi, true, nullptr);
    }
    ATT_SYNC();
    {
        const bf16_t* kw = KV6 + 4 * KV6_STRIDE + bg * S_ * HD; const bf16_t* vw = KV6 + 5 * KV6_STRIDE + bg * S_ * HD;
        Soft sw;
        const int nt = (n >= 8) ? 9 : n + 1;
        for (int rep_ = 0; rep_ < NSA_REP_WIN; ++rep_) {
        if (rep_) ATT_SYNC();
        soft_init(sw);
        dma_k(kw + (size_t)n * 64 * 64, 64, lds + NSA_LK, wid, lane); dma_v(vw + (size_t)n * 64 * 64, 64, lds + NSA_LV, wid, lane);
        ATT_SYNC();
        if (nt > 1) { dma_k(kw + (size_t)(n - 1) * 64 * 64, 64, lds + NSA_LK + 8192, wid, lane); dma_v(vw + (size_t)(n - 1) * 64 * 64, 64, lds + NSA_LV + 8192, wid, lane); }
        kload8(kf, lds + NSA_LK, r32, hi);
        int slot = 0;
        for (int i = 0; i < nt; ++i) {
            f32x16 p0, p1;
            if (i == 0) qkt_reg<false>(p0, p1, kf, qr, 0.f); else qkt_reg<true>(p0, p1, kf, qr, -sw.m);
            ATT_SB(); vload8(vf, vpl + slot * 8192, 0); ATT_SB();
            if (i == 0) { mask_le(p0, p1, tokl, hi, NEGINF); soft_step<true>(sw, p0, p1, wsf, r32, hi); } else { if (i == 8) mask_gt(p0, p1, tokl, hi, NEGINF); soft_step<false>(sw, p0, p1, wsf, r32, hi); }
            const int s1 = (slot == 2) ? 0 : slot + 1;
            if (i + 1 < nt) {
                ATT_SB(); asm volatile("s_waitcnt vmcnt(0)" ::: "memory"); __builtin_amdgcn_s_barrier(); asm volatile("" ::: "memory");
                if (i + 2 < nt) { const int s2 = (slot == 0) ? 2 : slot - 1; const int nn = n - i - 2; dma_k(kw + (size_t)nn * 64 * 64, 64, lds + NSA_LK + s2 * 8192, wid, lane); dma_v(vw + (size_t)nn * 64 * 64, 64, lds + NSA_LV + s2 * 8192, wid, lane); }
                kload8(kf, lds + NSA_LK + s1 * 8192, r32, hi); ATT_SB();
            }
            pv_reg(sw.o, sw.lacc, vf, vpl + slot * 8192, p0, p1);
            slot = s1;
        }
        }
        acc_store(accp, sw.o, &sw.lacc, wsf, gates[trow * 24 + hh * 3 + 2], r32, hi, true, Y + ((size_t)b * S_ + 64 * n + 32 * th) * YP + hh * 64 + r32);
    }
}

constexpr int DL_LK = 0, DL_LV = 49152, DL_WSF = 98304;
__device__ __forceinline__ void dil_unit(LAS unsigned char* lds, int b, int g, int h, int res, int lb, const bf16_t* DIL, bf16_t* DILO, float* DLSE, int wid, int lane) {
    const int r32 = lane & 31, hi = lane >> 5;
    const int dil = (g == 0) ? 1 : (g == 1 ? 4 : 16);
    const size_t hb = ((size_t)(b * 4 + h) * S_) * HD;
    const bf16_t* Qb = DIL + (size_t)(g * 3 + 0) * DIL_STRIDE + hb; const bf16_t* Kb = DIL + (size_t)(g * 3 + 1) * DIL_STRIDE + hb; const bf16_t* Vb = DIL + (size_t)(g * 3 + 2) * DIL_STRIDE + hb;
    LAS float* wsf = (LAS float*)(lds + DL_WSF + wid * 256);
    const unsigned vb = (unsigned)(uintptr_t)(lds + DL_LV) + ((lane >> 4) & 1) * 32 + (lane & 3) * 8 + (4 * hi + ((lane & 15) >> 2)) * 64;
    const int L0 = 256 * lb - 128;
    __syncthreads();
    for (int ti = 0; ti < 6; ++ti) { const int Lr = L0 + 64 * ti; if (Lr < 0) continue;
        dma_k(Kb + (size_t)(res + dil * Lr) * HD, (size_t)dil * HD, lds + DL_LK + ti * 8192, wid, lane); dma_v(Vb + (size_t)(res + dil * Lr) * HD, (size_t)dil * HD, lds + DL_LV + ti * 8192, wid, lane); }
    const int Lq = 256 * lb + 32 * wid + r32;
    const size_t tq = (size_t)res + (size_t)dil * Lq;
    bf16x8 qr[4];
#pragma unroll
    for (int d0 = 0; d0 < 4; ++d0) qr[d0] = *(const bf16x8*)(Qb + tq * HD + d0 * 16 + hi * 8);
    ATT_SYNC();
    Soft ss; soft_init(ss);
    const int lim = 32 * (wid & 1) + r32;
    for (int k = 2; k >= 0; --k) {
        const int ti = (wid >> 1) + k;
        if (L0 + 64 * ti < 0) continue;
        f32x16 p0, p1;
        if (k == 2) { qkt<false>(p0, p1, lds + DL_LK + ti * 8192, qr, 0.f, r32, hi); mask_le(p0, p1, lim, hi, -INFINITY); soft_step<true>(ss, p0, p1, wsf, r32, hi); }
        else { qkt<true>(p0, p1, lds + DL_LK + ti * 8192, qr, -ss.m, r32, hi); if (k == 0) mask_gt(p0, p1, lim - 1, hi, -INFINITY); soft_step<false>(ss, p0, p1, wsf, r32, hi); }
        pv<true>(ss.o, ss.lacc, vb + ti * 8192, p0, p1);
    }
    if (r32 == 0) {
#pragma unroll
        for (int r = 0; r < 16; ++r) wsf[32 + crow(r, hi)] = ss.lacc[r]; }
    asm volatile("s_waitcnt lgkmcnt(0)" ::: "memory");
    if (hi == 0) DLSE[((size_t)g * T_ + (size_t)b * S_ + tq) * 4 + h] = ss.m + __builtin_amdgcn_logf(wsf[32 + r32]);
    bf16_t* ob = DILO + ((size_t)g * T_ + (size_t)b * S_ + res + (size_t)dil * (256 * lb + 32 * wid)) * 256 + h * 64 + r32;
#pragma unroll
    for (int r = 0; r < 16; ++r) { const int q = crow(r, hi); const float fr = __builtin_amdgcn_rcpf(ss.lacc[r]);
        ob[(size_t)q * dil * 256] = f2bf(ss.o[0][r] * fr); ob[(size_t)q * dil * 256 + 32] = f2bf(ss.o[1][r] * fr); }
    asm volatile("s_waitcnt lgkmcnt(0)" ::: "memory");
}
}
namespace peer {
using att::crow; using att::max3f; using att::swap_max;
constexpr int RT_TOPS = 32768, RT_TOPS_WAVE = 64 * 33 * 4;
__device__ __forceinline__ float drop_eq(float v, float M, float ninf) { float r; asm volatile("v_cmp_eq_f32 vcc, %1, %2\n\tv_cndmask_b32 %0, %2, %3, vcc" : "=v"(r) : "v"(M), "v"(v), "v"(ninf) : "vcc"); return r; }
__device__ __forceinline__ void cex(float& a, float& b) { const float hi_ = fmaxf(a, b), lo_ = fminf(a, b); a = hi_; b = lo_; }
__device__ __forceinline__ void bitonic_merge16(f32x16& v) {
#pragma unroll
    for (int j = 8; j >= 1; j >>= 1)
#pragma unroll
        for (int i = 0; i < 16; ++i) if ((i & j) == 0) { float a = v[i], b = v[i | j]; cex(a, b); v[i] = a; v[i | j] = b; }
}
__device__ __forceinline__ void sort16(f32x16& v) {
#pragma unroll
    for (int k = 2; k <= 16; k <<= 1)
#pragma unroll
        for (int j = k >> 1; j >= 1; j >>= 1)
#pragma unroll
            for (int i = 0; i < 16; ++i) { const int l = i ^ j; if (l > i) { float a = v[i], b = v[l]; const bool desc = ((i & k) == 0) || (k == 16); if (desc) cex(a, b); else cex(b, a); v[i] = a; v[l] = b; } }
}
__device__ __forceinline__ void merge_top16(f32x16& a, const f32x16& b) {
#pragma unroll
    for (int i = 0; i < 16; ++i) a[i] = fmaxf(a[i], b[15 - i]);
    bitonic_merge16(a);
}
__device__ __forceinline__ void route_unit(LAS unsigned char* lds, int tok0, int hp, const bf16_t* PQ, int* IDX, float* GS, int wid, int lane) {
    const int r32 = lane & 31, hi = lane >> 5;
    LAS float* tops = (LAS float*)(lds + RT_TOPS + wid * RT_TOPS_WAVE);
    const float NINF = -INFINITY; const unsigned hi4 = 4u * (unsigned)hi;
    bf16x8 qall[4][4];
#pragma unroll
    for (int rd = 0; rd < 4; ++rd)
#pragma unroll
        for (int d0 = 0; d0 < 4; ++d0) qall[rd][d0] = *(const bf16x8*)(PQ + (size_t)(tok0 + r32) * 1024 + (hp * 2 + (rd >> 1)) * 128 + (rd & 1) * 64 + d0 * 16 + hi * 8);
#pragma unroll
    for (int hl = 0; hl < 2; ++hl)
#pragma unroll
        for (int c = 0; c < 2; ++c) {
            const bf16x8 (&qr)[4] = qall[hl * 2 + c];
            f32x16 p[4];
            const LAS unsigned char* kbase = lds + c * 16384 + hi * 2048 + r32 * 16;
#pragma unroll
            for (int kb = 0; kb < 4; ++kb) {
                f32x16 z;
#pragma unroll
                for (int i = 0; i < 16; ++i) z[i] = 0.f;
#pragma unroll
                for (int d0 = 0; d0 < 4; ++d0) { const bf16x8 af = *(const LAS bf16x8*)(kbase + d0 * 4096 + kb * 512); p[kb] = __builtin_amdgcn_mfma_f32_32x32x16_bf16(af, qr[d0], d0 == 0 ? z : p[kb], 0, 0, 0); }
            }
            asm volatile("s_nop 15\n\ts_nop 7" : "+v"(p[0]), "+v"(p[1]), "+v"(p[2]), "+v"(p[3]));
#pragma unroll
            for (int kb = 0; kb < 4; ++kb)
#pragma unroll
                for (int r = 0; r < 16; ++r) { const unsigned K = 127u - 32u * kb - (unsigned)((r & 3) + 8 * (r >> 2)); p[kb][r] = __uint_as_float(((__float_as_uint(p[kb][r]) & 0xFFFFFF80u) | K) - hi4); }
            sort16(p[0]); sort16(p[1]); sort16(p[2]); sort16(p[3]);
            merge_top16(p[0], p[1]); merge_top16(p[2], p[3]); merge_top16(p[0], p[2]);
            {
                f32x16 q;
#pragma unroll
                for (int i = 0; i < 16; ++i) { auto rr = __builtin_amdgcn_permlane32_swap(__float_as_uint(p[0][i]), __float_as_uint(p[0][i]), false, false); q[i] = __uint_as_float(hi ? rr[0] : rr[1]); }
#pragma unroll
                for (int i = 0; i < 16; ++i) p[1][i] = fmaxf(p[0][i], q[15 - i]);
                bitonic_merge16(p[1]);
            }
            if (hi == 0) {
#pragma unroll
                for (int it = 0; it < 16; ++it) tops[(hl * 32 + r32) * 33 + c * 16 + it] = p[1][it]; }
        }
    asm volatile("s_waitcnt lgkmcnt(0)" ::: "memory");
    const LAS float* my = tops + lane * 33;
    float s1[16], s2[16];
#pragma unroll
    for (int k = 0; k < 16; ++k) { s1[k] = my[k]; s2[k] = my[16 + k]; }
    f32x16 cb[4];
    {
        int n = 0;
#pragma unroll
        for (int a = 0; a < 16; ++a)
#pragma unroll
            for (int b = 0; b < 16; ++b) if ((a + 1) * (b + 1) <= 16) { cb[n >> 4][n & 15] = __uint_as_float((__float_as_uint(s1[a] + s2[b]) & 0xFFFFFF00u) | (unsigned)(255 - (16 * a + b))); ++n; }
#pragma unroll
        for (int k = 50; k < 64; ++k) cb[k >> 4][k & 15] = NINF;
    }
    sort16(cb[0]); sort16(cb[1]); sort16(cb[2]); sort16(cb[3]);
    merge_top16(cb[0], cb[1]); merge_top16(cb[2], cb[3]); merge_top16(cb[0], cb[2]);
    float rk[16];
#pragma unroll
    for (int k = 0; k < 16; ++k) rk[k] = cb[0][k];
    float den = 0.f, ev[16];
#pragma unroll
    for (int k = 0; k < 16; ++k) { ev[k] = __expf(rk[k] - rk[0]); den += ev[k]; }
    const float inv = 1.f / den;
    const int t = tok0 + r32, h = hp * 2 + hi;
    int* ip = IDX + (size_t)t * 128 + h * 16; float* gp = GS + (size_t)t * 128 + h * 16;
#pragma unroll
    for (int k4 = 0; k4 < 4; ++k4) {
        u32x4 iv; f32x4 gv;
#pragma unroll
        for (int i = 0; i < 4; ++i) { const int k = k4 * 4 + i; const unsigned pid = 255u - (__float_as_uint(rk[k]) & 255u); const unsigned aa = pid >> 4, bb = pid & 15u;
            const unsigned i1 = 127u - (__float_as_uint(my[aa]) & 127u), i2 = 127u - (__float_as_uint(my[16 + bb]) & 127u); iv[i] = i1 * 128u + i2; gv[i] = ev[k] * inv; }
        *(u32x4*)(ip + k4 * 4) = iv; *(f32x4*)(gp + k4 * 4) = gv;
    }
    asm volatile("s_waitcnt lgkmcnt(0)" ::: "memory");
}

typedef float f32x2 __attribute__((ext_vector_type(2)));
constexpr float SU = 64.f, SV = 5.5f;
typedef unsigned u32x6 __attribute__((ext_vector_type(6)));
typedef float f32x32 __attribute__((ext_vector_type(32)));
constexpr int ROWB = 512;
constexpr int ROWBV = 512;
typedef __amdgpu_buffer_rsrc_t rsrc_t;
typedef int i32x8 __attribute__((ext_vector_type(8)));
template <int CTRL> __device__ __forceinline__ float dpp_mov(float x) { return __uint_as_float(__builtin_amdgcn_update_dpp(0, __float_as_uint(x), CTRL, 0xf, 0xf, false)); }
template <int EMASK> __device__ __forceinline__ void expert_lists(int X, int e_lo, int e_hi, float g_lo, float g_hi, int lane, LAS unsigned char* wl) {
    const int c_lo = (e_lo >> 3) & 15, c_hi = (e_hi >> 3) & 15; const unsigned long long lt = (1ull << lane) - 1ull;
    int base = 0, r_lo = 0, r_hi = 0;
    for (int c = 0; c < 16; ++c) { const unsigned long long mlo = __ballot(c_lo == c), mhi = __ballot(c_hi == c); const int nlo = (int)__builtin_popcountll(mlo);
        if (c_lo == c) r_lo = base + (int)__builtin_popcountll(mlo & lt);
        if (c_hi == c) r_hi = base + nlo + (int)__builtin_popcountll(mhi & lt);
        base += nlo + (int)__builtin_popcountll(mhi); }
    ((LAS int*)wl)[X * 128 + ((r_lo & ~7) | ((r_lo & 1) << 2) | ((r_lo >> 1) & 3))] = e_lo & EMASK; ((LAS int*)wl)[X * 128 + ((r_hi & ~7) | ((r_hi & 1) << 2) | ((r_hi >> 1) & 3))] = e_hi & EMASK;
    ((LAS float*)(wl + 1024))[X * 128 + r_lo] = g_lo; ((LAS float*)(wl + 1024))[X * 128 + r_hi] = g_hi;
}
__device__ __forceinline__ void expert_selector_table(LAS unsigned char* selT, int tid) {
    const int c = tid >> 5, m = tid & 31; const unsigned code = ((unsigned)(c >> 3) << 5) | 8u | (unsigned)(c & 7); const int pos = 6 * m, w0 = pos >> 5, sh = pos & 31;
    const unsigned lo = code << sh, hi = (sh > 26) ? (code >> (32 - sh)) : 0u; unsigned d[8];
#pragma unroll
    for (int w = 0; w < 8; ++w) d[w] = ((w == w0) ? lo : 0u) | ((w == w0 + 1) ? hi : 0u);
    *(LAS u32x4*)(selT + tid * 32) = (u32x4){d[0], d[1], d[2], d[3]}; *(LAS u32x4*)(selT + tid * 32 + 16) = (u32x4){d[4], d[5], d[6], d[7]};
}
template <int EMASK = 0xffff> __device__ __forceinline__ void expert_mfma4(int tA0, int tB0, int tA1, int tB1, const bf16_t* HN, const unsigned char* U8, const unsigned char* V8, const int* IDX, const float* GS, const float* SSQ, float* out, int lane, LAS unsigned char* hq, const LAS unsigned char* selT, LAS unsigned char* wl) {
    const rsrc_t ur = __builtin_amdgcn_make_buffer_rsrc((void*)U8, 0, 16 << 20, 0x00020000), vr = __builtin_amdgcn_make_buffer_rsrc((void*)V8, 0, 16 << 20, 0x00020000);
    const int h = lane >> 5, l31 = lane & 31, cb = l31 * 16;
    const int r = lane & 15, kb = lane >> 4, sl = r & 3, ca = 64 * kb + 16 * sl;
    const int tme0 = h ? tB0 : tA0, tme1 = h ? tB1 : tA1;
    const int e0[4] = {IDX[(size_t)tA0 * 128 + lane], IDX[(size_t)tA0 * 128 + 64 + lane], IDX[(size_t)tB0 * 128 + lane], IDX[(size_t)tB0 * 128 + 64 + lane]};
    const int e1[4] = {IDX[(size_t)tA1 * 128 + lane], IDX[(size_t)tA1 * 128 + 64 + lane], IDX[(size_t)tB1 * 128 + lane], IDX[(size_t)tB1 * 128 + 64 + lane]};
    const float g0[4] = {GS[(size_t)tA0 * 128 + lane], GS[(size_t)tA0 * 128 + 64 + lane], GS[(size_t)tB0 * 128 + lane], GS[(size_t)tB0 * 128 + 64 + lane]};
    const float g1[4] = {GS[(size_t)tA1 * 128 + lane], GS[(size_t)tA1 * 128 + 64 + lane], GS[(size_t)tB1 * 128 + lane], GS[(size_t)tB1 * 128 + 64 + lane]};
    const f32x4* sp0 = (const f32x4*)(SSQ + (size_t)tme0 * 16); const f32x4 sq0 = (sp0[0] + sp0[1]) + (sp0[2] + sp0[3]);
    const f32x4* sp1 = (const f32x4*)(SSQ + (size_t)tme1 * 16); const f32x4 sq1 = (sp1[0] + sp1[1]) + (sp1[2] + sp1[3]);
    u32x2 hw0[8], hw1[8];
    { const u32x2* hp0 = (const u32x2*)(HN + (size_t)tme0 * 1024 + 4 * l31); const u32x2* hp1 = (const u32x2*)(HN + (size_t)tme1 * 1024 + 4 * l31);
#pragma unroll
      for (int k = 0; k < 8; ++k) { hw0[k] = hp0[32 * k]; hw1[k] = hp1[32 * k]; } }
    f32x16 acc0A, acc0B, acc1A, acc1B;
#define EM_ACCIN(ACCA, ACCB, HW) do { _Pragma("unroll") for (int rq = 0; rq < 4; ++rq) { \
        const unsigned ox_ = h ? HW[2 * rq + 1][0] : HW[2 * rq][0], oy_ = h ? HW[2 * rq + 1][1] : HW[2 * rq][1], sx_ = h ? HW[2 * rq][0] : HW[2 * rq + 1][0], sy_ = h ? HW[2 * rq][1] : HW[2 * rq + 1][1]; \
        auto rx_ = __builtin_amdgcn_permlane32_swap(sx_, sx_, false, false); auto ry_ = __builtin_amdgcn_permlane32_swap(sy_, sy_, false, false); \
        const unsigned px_ = h ? rx_[0] : rx_[1], py_ = h ? ry_[0] : ry_[1];              \
        const unsigned ax_ = h ? px_ : ox_, ay_ = h ? py_ : oy_, bx_ = h ? ox_ : px_, by_ = h ? oy_ : py_;        \
        ACCA[4 * rq] = __uint_as_float(ax_ << 16); ACCA[4 * rq + 1] = __uint_as_float(ax_ & 0xffff0000u); ACCA[4 * rq + 2] = __uint_as_float(ay_ << 16); ACCA[4 * rq + 3] = __uint_as_float(ay_ & 0xffff0000u); \
        ACCB[4 * rq] = __uint_as_float(bx_ << 16); ACCB[4 * rq + 1] = __uint_as_float(bx_ & 0xffff0000u); ACCB[4 * rq + 2] = __uint_as_float(by_ << 16); ACCB[4 * rq + 3] = __uint_as_float(by_ & 0xffff0000u); } } while (0)
    EM_ACCIN(acc0A, acc0B, hw0); EM_ACCIN(acc1A, acc1B, hw1);
#undef EM_ACCIN
    expert_lists<EMASK>(0, e0[0], e0[1], g0[0], g0[1], lane, wl); expert_lists<EMASK>(1, e0[2], e0[3], g0[2], g0[3], lane, wl);
    expert_lists<EMASK>(0, e1[0], e1[1], g1[0], g1[1], lane, wl + 2048); expert_lists<EMASK>(1, e1[2], e1[3], g1[2], g1[3], lane, wl + 2048);
    u32x4 b40[2], b41[2]; u32x2 b20[2], b21[2];
#define EM_HB(HW, SQ, B4, B2) do { f32x16 ev, od; const float hs_ = 2.f * __builtin_amdgcn_rsqf(((SQ[0] + SQ[1]) + (SQ[2] + SQ[3])) * (1.f / 1024.f) + EPS); \
      _Pragma("unroll") for (int k = 0; k < 8; ++k) { const u32x2 w = HW[k]; ev[2 * k] = __builtin_amdgcn_fmed3f(hs_ * __uint_as_float(w[0] << 16), -7.5f, 7.5f); od[2 * k] = __builtin_amdgcn_fmed3f(hs_ * __uint_as_float(w[0] & 0xffff0000u), -7.5f, 7.5f); \
          ev[2 * k + 1] = __builtin_amdgcn_fmed3f(hs_ * __uint_as_float(w[1] << 16), -7.5f, 7.5f); od[2 * k + 1] = __builtin_amdgcn_fmed3f(hs_ * __uint_as_float(w[1] & 0xffff0000u), -7.5f, 7.5f); } \
      const u32x6 pk = __builtin_amdgcn_cvt_scalef32_2xpk16_fp6_f32(ev, od, 1.0f); \
      asm volatile("s_waitcnt lgkmcnt(0)" ::: "memory"); \
      *(LAS u32x4*)(hq + (h * 32 + l31) * 32) = (u32x4){pk[0], pk[1], pk[2], pk[3]}; *(LAS u32x2*)(hq + (h * 32 + l31) * 32 + 16) = (u32x2){pk[4], pk[5]}; \
      asm volatile("s_waitcnt lgkmcnt(0)" ::: "memory"); \
      _Pragma("unroll") for (int j = 0; j < 2; ++j) { const LAS unsigned char* bp = hq + ((((r >> 2) & 1) * 32) + 16 * j + 4 * kb + sl) * 32; B4[j] = *(const LAS u32x4*)bp; B2[j] = *(const LAS u32x2*)(bp + 16); } \
      asm volatile("s_waitcnt lgkmcnt(0)" ::: "memory"); } while (0)
    EM_HB(hw0, sq0, b40, b20); EM_HB(hw1, sq1, b41, b21);
#undef EM_HB
    u32x4 a4[8], vb[8];
    const LAS unsigned char* idA = wl + ((r >> 3) * 128 + ((r >> 2) & 1) * 4) * 4;
    const LAS unsigned char* idV0 = wl + (h * 4) * 4, * idV1 = wl + (128 + h * 4) * 4;
    const LAS unsigned char* gtp = wl + 1024 + (((lane >> 3) & 1) * 128 + (lane & 7)) * 4;
    LAS int* const pks = (LAS int*)(wl + 4096);
#define EM_LOADA(tk, LB) do { const u32x4 ia_ = *(const LAS u32x4*)(idA + (LB) + 32 * (tk)); _Pragma("unroll") for (int g = 0; g < 4; ++g) { const int ro_ = (int)((ia_[g] << 9) | (unsigned)ca); \
        _Pragma("unroll") for (int j = 0; j < 2; ++j) a4[2 * g + j] = __builtin_amdgcn_raw_buffer_load_b128(ur, ro_ + 256 * j, 0, 0); } } while (0)
#define EM_LOADV2(X, g, IV) do { vb[4 * (X) + (g)] = __builtin_amdgcn_raw_buffer_load_b128(vr, (int)((IV[g] << 9) | (unsigned)cb), 0, 0); } while (0)
#define EM_VMFMA(X, g, ACC) do { const int pk_ = pkc[4 * (X) + (g)]; const LAS unsigned char* sp_ = selT + (((unsigned)pk_ >> 8) & 15u) * 1024 + l31 * 32; const u32x4 s4_ = *(const LAS u32x4*)sp_; const u32x2 s2_ = *(const LAS u32x2*)(sp_ + 16); \
        const i32x8 As_ = {(int)s4_[0], (int)s4_[1], (int)s4_[2], (int)s4_[3], (int)s2_[0], (int)s2_[1], 0, 0}, Bv_ = {(int)vb[4 * (X) + (g)][0], (int)vb[4 * (X) + (g)][1], (int)vb[4 * (X) + (g)][2], (int)vb[4 * (X) + (g)][3], 0, 0, 0, 0}; \
        ACC = __builtin_amdgcn_mfma_scale_f32_32x32x64_f8f6f4(As_, Bv_, ACC, 2, 4, 0, pk_, 0, 0x7F7F7F7F); } while (0)
#define EM_VGROUP(g, PA, PB) do { EM_VMFMA(0, g, PA); EM_VMFMA(1, g, PB); asm volatile("" : "+v"(PA), "+v"(PB)); } while (0)
#define EM_STEP(tk, LB, B4, B2, PA, PB, NTK, NLB) do { \
        __builtin_amdgcn_s_barrier();       \
        float pd[4]; \
        _Pragma("unroll") for (int g = 0; g < 4; ++g) { f32x4 c = {0.f, 0.f, 0.f, 0.f}; \
            _Pragma("unroll") for (int j = 0; j < 2; ++j) { const i32x8 A = {(int)a4[2 * g + j][0], (int)a4[2 * g + j][1], (int)a4[2 * g + j][2], (int)a4[2 * g + j][3], 0, 0, 0, 0}, Bm = {(int)B4[j][0], (int)B4[j][1], (int)B4[j][2], (int)B4[j][3], (int)B2[j][0], (int)B2[j][1], 0, 0}; \
                c = __builtin_amdgcn_mfma_scale_f32_16x16x128_f8f6f4(A, Bm, c, 4, 2, 0, 0x7F7F7F7F, 0, 0x7E7E7E7E); } \
            pd[g] = (lane & 2) ? ((lane & 1) ? c[3] : c[2]) : ((lane & 1) ? c[1] : c[0]); } \
        asm volatile("" : "+v"(pd[0]), "+v"(pd[1]), "+v"(pd[2]), "+v"(pd[3])); \
        EM_LOADA(NTK, NLB); \
        const u32x4 iv0_ = *(const LAS u32x4*)(idV0 + (LB) + 32 * (tk)), iv1_ = *(const LAS u32x4*)(idV1 + (LB) + 32 * (tk)); const float gk_ = *(const LAS float*)(gtp + (LB) + 32 * (tk)); \
        _Pragma("unroll") for (int g = 0; g < 4; ++g) { pd[g] += dpp_mov<0xB1>(pd[g]); pd[g] += dpp_mov<0x4E>(pd[g]); } \
        const int sl_ = ((lane >> 3) & 1) * 36 + (lane & 1) * 16; \
        const float x0 = __shfl(pd[0], sl_), x1 = __shfl(pd[1], sl_), x2 = __shfl(pd[2], sl_), x3 = __shfl(pd[3], sl_); \
        __builtin_amdgcn_sched_barrier(0); \
        EM_VGROUP(0, PA, PB); EM_LOADV2(0, 0, iv0_); EM_LOADV2(1, 0, iv1_); \
        __builtin_amdgcn_sched_barrier(0); \
        const float dot_ = (lane & 4) ? ((lane & 2) ? x3 : x2) : ((lane & 2) ? x1 : x0); \
        const float act_ = gelu_tanh(dot_ * (1.f / SU)) * gk_ * (1.f / SV); \
        __builtin_amdgcn_sched_barrier(0); \
        EM_VGROUP(1, PA, PB); EM_LOADV2(0, 1, iv0_); EM_LOADV2(1, 1, iv1_); \
        __builtin_amdgcn_sched_barrier(0); \
        { const unsigned ab_ = __float_as_uint(act_), rb_ = (ab_ & 0x7fffffffu) + (1u << 19); pks[pkslot] = (int)((rb_ >> 23) | ((ab_ >> 31) << 11) | (((rb_ >> 20) & 7u) << 8)); } \
        __builtin_amdgcn_sched_barrier(0); \
        EM_VGROUP(2, PA, PB); EM_LOADV2(0, 2, iv0_); EM_LOADV2(1, 2, iv1_); \
        __builtin_amdgcn_sched_barrier(0); \
        asm volatile("s_waitcnt lgkmcnt(0)" ::: "memory"); \
        const u32x4 q0_ = *(const LAS u32x4*)(pks + 8 * h), q1_ = *(const LAS u32x4*)(pks + 8 * h + 4); \
        __builtin_amdgcn_sched_barrier(0); \
        EM_VGROUP(3, PA, PB); EM_LOADV2(0, 3, iv0_); EM_LOADV2(1, 3, iv1_); \
        __builtin_amdgcn_sched_barrier(0); \
        asm volatile("s_waitcnt lgkmcnt(0)" ::: "memory"); \
        _Pragma("unroll") for (int i = 0; i < 4; ++i) { pkc[i] = (int)q0_[i]; pkc[4 + i] = (int)q1_[i]; } } while (0)
    int pkc[8];
#pragma unroll
    for (int i = 0; i < 8; ++i) pkc[i] = 0;
    const int pkslot = (lane & 1) * 8 + ((lane >> 3) & 1) * 4 + ((lane >> 1) & 3) + 32 * (lane >> 4);
    asm volatile("s_waitcnt lgkmcnt(0)" ::: "memory");
    EM_LOADA(0, 0);
    { const u32x4 iv0_ = *(const LAS u32x4*)idV0, iv1_ = *(const LAS u32x4*)idV1; EM_LOADV2(0, 0, iv0_); EM_LOADV2(1, 0, iv1_); EM_LOADV2(0, 1, iv0_); EM_LOADV2(1, 1, iv1_); EM_LOADV2(0, 2, iv0_); EM_LOADV2(1, 2, iv1_); EM_LOADV2(0, 3, iv0_); EM_LOADV2(1, 3, iv1_); }
#pragma unroll 1
    for (int tk = 0; tk < 16; ++tk) {
        EM_STEP(tk, 0, b40, b20, acc1A, acc1B, tk, 2048);
        EM_STEP(tk, 2048, b41, b21, acc0A, acc0B, (tk + 1) & 15, 0);
    }
    EM_VGROUP(0, acc1A, acc1B); EM_VGROUP(1, acc1A, acc1B); __builtin_amdgcn_sched_barrier(0); EM_VGROUP(2, acc1A, acc1B); EM_VGROUP(3, acc1A, acc1B);
#undef EM_STEP
#undef EM_LOADA
#undef EM_LOADV2
#undef EM_VMFMA
#undef EM_VGROUP
#define EM_ACCOUT(ACC, T) do { const int to_ = (EMASK == 0xffff) ? (T) : ((T) & 16383); f32x4* o_ = (f32x4*)(out + (size_t)to_ * 1024 + 128 * h + 4 * l31); \
        _Pragma("unroll") for (int rq = 0; rq < 4; ++rq) o_[64 * rq] = (f32x4){ACC[4 * rq], ACC[4 * rq + 1], ACC[4 * rq + 2], ACC[4 * rq + 3]}; } while (0)
    EM_ACCOUT(acc0A, tA0); EM_ACCOUT(acc0B, tB0); EM_ACCOUT(acc1A, tA1); EM_ACCOUT(acc1B, tB1);
#undef EM_ACCOUT
}
}
constexpr int NWAVES = 8, NTHREADS = 512;
constexpr int RING_BYTES = 131072;
constexpr int LDS_BYTES = 147456;
constexpr int NPH = 11;

#ifndef DUP_MASK
#define DUP_MASK 0
#endif
#define RLX_AGENT __ATOMIC_RELAXED, __HIP_MEMORY_SCOPE_AGENT
#define XB_TMO      128
#define XB_XCNT(j)  (256  + 64 * (j))
#define XB_XSUB(j)  (1280 + 64 * (j))
#define XB_XGEN(j)  (2304 + 64 * (j))
#define XB_TOP      3328
#define XB_TOPGEN   3392
#define XCD_BAR_WORDS 3456
#define XB_SPIN_CAP (1u << 18)

__device__ __forceinline__ unsigned xb_ld(unsigned* p)              { return __hip_atomic_load(p, __ATOMIC_RELAXED, __HIP_MEMORY_SCOPE_AGENT); }
__device__ __forceinline__ unsigned xb_add(unsigned* p, unsigned v) { return __hip_atomic_fetch_add(p, v, __ATOMIC_RELAXED, __HIP_MEMORY_SCOPE_AGENT); }
__device__ __forceinline__ unsigned xb_xcc_id() { return (unsigned)__builtin_amdgcn_s_getreg((3 << 11) | 20) & 0xFu; }
#define XB_SPIN(cond, bar) do { unsigned _sp = 0; while (cond) { __builtin_amdgcn_s_sleep(1); \
    if ((++_sp & 255u) == 0u) { if (xb_ld(&(bar)[XB_TMO])) break; if (_sp > XB_SPIN_CAP) { atomicAdd(&(bar)[XB_TMO], 1u); break; } } } } while (0)

struct XcdBarrier {
    unsigned* bar; unsigned x;
    volatile LAS unsigned* st;
};

__device__ __forceinline__ XcdBarrier xcd_barrier_post(unsigned* bar, volatile LAS unsigned* st) {
    XcdBarrier b; b.bar = bar; b.x = xb_xcc_id(); b.st = st;
    if (threadIdx.x == 0) (void)xb_add(&bar[XB_XCNT(b.x)], 1u);
    return b;
}
__device__ __forceinline__ void xcd_barrier_complete(unsigned* bar, unsigned x, unsigned& nloc, unsigned& nx) {
    const unsigned G = gridDim.x * gridDim.y * gridDim.z;
    unsigned sum, cnt, mine, sp = 0u;
    for (;;) {
        sum = 0u; cnt = 0u; mine = 0u;
#pragma unroll
        for (unsigned j = 0; j < 16; ++j) { const unsigned c = xb_ld(&bar[XB_XCNT(j)]); sum += c; cnt += (c > 0u) ? 1u : 0u; mine = (j == x) ? c : mine; }
        if (sum == G) break;
        __builtin_amdgcn_s_sleep(1);
        if ((++sp & 255u) == 0u) { if (xb_ld(&bar[XB_TMO])) break; if (sp > XB_SPIN_CAP) { atomicAdd(&bar[XB_TMO], 1u); break; } }
    }
    nloc = mine > 0u ? mine : 1u; nx = cnt > 0u ? cnt : 1u;
}

__device__ __forceinline__ void xcd_barrier(const XcdBarrier& b) {
    asm volatile("s_waitcnt vmcnt(0)" ::: "memory");
    __syncthreads();
    if (threadIdx.x == 0) {
        unsigned* bar = b.bar;
        __builtin_amdgcn_s_waitcnt(0);
        unsigned nloc = b.st[0], nx = b.st[1];
        if (nloc == 0u) { xcd_barrier_complete(bar, b.x, nloc, nx); b.st[0] = nloc; b.st[1] = nx; }
        const unsigned old = xb_add(&bar[XB_XSUB(b.x)], 1u);
        const unsigned gen = old / nloc;
        if (old + 1u == (gen + 1u) * nloc) {
            __builtin_amdgcn_fence(__ATOMIC_RELEASE, "agent");
            asm volatile("s_waitcnt vmcnt(0)" ::: "memory");
            const unsigned og = xb_add(&bar[XB_TOP], 1u);
            const unsigned tg = og / nx;
            if (og + 1u == (tg + 1u) * nx) xb_add(&bar[XB_TOPGEN], 1u);
            else XB_SPIN(xb_ld(&bar[XB_TOPGEN]) == tg, bar);
            __builtin_amdgcn_fence(__ATOMIC_ACQUIRE, "agent");
            xb_add(&bar[XB_XGEN(b.x)], 1u);
            asm volatile("s_waitcnt vmcnt(0)" ::: "memory");
        } else {
            XB_SPIN(xb_ld(&bar[XB_XGEN(b.x)]) == gen, bar);
            __builtin_amdgcn_fence(__ATOMIC_ACQUIRE, "agent");
            asm volatile("s_waitcnt vmcnt(0)" ::: "memory");
        }
    }
    __syncthreads();
}
constexpr int MISC_OFF = LDS_BYTES - 64;
struct Args { const float* in[21]; float* out; unsigned char* ws; int ph_lo, ph_hi, dup, pad; };

struct Frame { LAS unsigned char* lds; int tid, lane, wave, G, vcu, gw, NGW; };

#define LDS_WAIT() asm volatile("s_waitcnt lgkmcnt(0)" ::: "memory")

__device__ __forceinline__ void p0_transpose_item(const float* W, int ldw, int skip_at, int skip, bf16_t* WT, int ldo, int koff, int nblk, LAS float* scr, int item, int lane, const float* kscale = nullptr) {
    const int kb = item / nblk, nb = item % nblk, k0 = 64 * kb, n0 = 32 * nb;
    const int nsrc = n0 + (lane & 31) + ((n0 >= skip_at) ? skip : 0);
#pragma unroll 8
    for (int i = 0; i < 32; ++i) { const int kk = 2 * i + (lane >> 5); float w_ = W[(size_t)(k0 + kk) * ldw + nsrc]; if (kscale) w_ *= kscale[k0 + kk]; scr[kk * 33 + (lane & 31)] = w_; }
    LDS_WAIT(); asm volatile("" ::: "memory");
    const int c = lane & 7;
#pragma unroll
    for (int j = 0; j < 4; ++j) { const int n = (lane >> 3) + 8 * j; const LAS float* s = scr + (8 * c) * 33 + n;
        u32x4 o; o.x = pk2(s[0 * 33], s[1 * 33]); o.y = pk2(s[2 * 33], s[3 * 33]); o.z = pk2(s[4 * 33], s[5 * 33]); o.w = pk2(s[6 * 33], s[7 * 33]);
        *(u32x4*)(WT + (size_t)(n0 + n) * ldo + koff + k0 + 8 * c) = o; }
    LDS_WAIT(); asm volatile("" ::: "memory");
}

__device__ __forceinline__ void norm_rows4(const float* src, const float* gain, bf16_t* dst, int gw, int NGW, int lane) {
    f32x4 gv[4];
#pragma unroll
    for (int j = 0; j < 4; ++j) gv[j] = ((const f32x4*)gain)[lane + 64 * j];
    for (int row0 = gw * 4; row0 < T_; row0 += NGW * 4) {
        f32x4 v[4][4]; float ss[4];
#pragma unroll
        for (int r = 0; r < 4; ++r) { const f32x4* xr = (const f32x4*)(src + (size_t)(row0 + r) * D_);
#pragma unroll
            for (int j = 0; j < 4; ++j) v[r][j] = xr[lane + 64 * j]; }
#pragma unroll
        for (int r = 0; r < 4; ++r) { ss[r] = 0.f;
#pragma unroll
            for (int j = 0; j < 4; ++j) ss[r] += v[r][j].x * v[r][j].x + v[r][j].y * v[r][j].y + v[r][j].z * v[r][j].z + v[r][j].w * v[r][j].w; }
#pragma unroll
        for (int o = 1; o < 64; o <<= 1) {
#pragma unroll
            for (int r = 0; r < 4; ++r) ss[r] += __shfl_xor(ss[r], o); }
#pragma unroll
        for (int r = 0; r < 4; ++r) { const float rstd = rsqrtf(ss[r] * (1.f / D_) + EPS);
#pragma unroll
            for (int j = 0; j < 4; ++j) { const f32x4 w = v[r][j] * rstd * gv[j]; u32x2 o; o.x = pk2(w.x, w.y); o.y = pk2(w.z, w.w); ((u32x2*)(dst + (size_t)(row0 + r) * D_))[lane + 64 * j] = o; } }
    }
}

template <bool G2> __device__ __forceinline__ void fp4_table(const f32x4* src, const f32x4* g2v, unsigned char* dst, float sc, int gt, int NGT) {
    for (int i = gt; i < 16384 * 32; i += NGT) { const int row = i >> 5, j = i & 31; f32x4 v[8];
#pragma unroll
        for (int k = 0; k < 8; ++k) v[k] = src[(size_t)row * 256 + 32 * k + j];
        if (G2) {
#pragma unroll
            for (int k = 0; k < 8; ++k) v[k] = v[k] * g2v[32 * k + j]; }
        u32x4 pk = {0u, 0u, 0u, 0u};
#pragma unroll
        for (int w = 0; w < 4; ++w) { unsigned x = 0u;
            x = __builtin_amdgcn_cvt_scalef32_pk_fp4_f32(x, v[2 * w][0] * sc, v[2 * w][1] * sc, 1.0f, 0); x = __builtin_amdgcn_cvt_scalef32_pk_fp4_f32(x, v[2 * w][2] * sc, v[2 * w][3] * sc, 1.0f, 1);
            x = __builtin_amdgcn_cvt_scalef32_pk_fp4_f32(x, v[2 * w + 1][0] * sc, v[2 * w + 1][1] * sc, 1.0f, 2); x = __builtin_amdgcn_cvt_scalef32_pk_fp4_f32(x, v[2 * w + 1][2] * sc, v[2 * w + 1][3] * sc, 1.0f, 3); pk[w] = x; }
        *(u32x4*)(dst + (size_t)row * 512 + 16 * j) = pk; }
}
__device__ __forceinline__ void phase0(const Frame& F, const Args& a) {
    unsigned char* ws = a.ws;
    const float* x = a.in[0]; const float* g1 = a.in[1]; const float* w_in = a.in[2];
    {
        LAS float* scr = (LAS float*)(F.lds + F.wave * 16384);
        constexpr int I_IN = 16 * 176, I_UPN = 8 * 32, I_UPD = 4 * 32, I_O = 16 * 32, I_Q = 16 * 32, I_C1 = 32 * 8;
        constexpr int NITEMS = I_IN + I_UPN + I_UPD + I_O + I_Q + 2 * I_C1;
        for (int it = F.gw; it < NITEMS; it += F.NGW) {
            int r = it;
            if (r < I_IN) { p0_transpose_item(w_in, IN_COLS, 1280, 24, (bf16_t*)(ws + WS_WTIN), 1024, 0, 176, scr, r, F.lane); continue; } r -= I_IN;
            if (r < I_UPN) { p0_transpose_item(a.in[13], 1024, 1 << 30, 0, (bf16_t*)(ws + WS_WTCAT), YP, 0, 32, scr, r, F.lane); continue; } r -= I_UPN;
            if (r < I_UPD) { p0_transpose_item(a.in[14], 1024, 1 << 30, 0, (bf16_t*)(ws + WS_WTCAT), YP, 512, 32, scr, r, F.lane); continue; } r -= I_UPD;
            if (r < I_O) { p0_transpose_item(a.in[15], 1024, 1 << 30, 0, (bf16_t*)(ws + WS_WTO), 1024, 0, 32, scr, r, F.lane); continue; } r -= I_O;
            if (r < I_Q) { p0_transpose_item(a.in[17], 1024, 1 << 30, 0, (bf16_t*)(ws + WS_WTQ), 1024, 0, 32, scr, r, F.lane, a.in[16]); continue; } r -= I_Q;
            if (r < I_C1) { p0_transpose_item(a.in[6], 256, 1 << 30, 0, (bf16_t*)(ws + WS_WTC1K), 2048, 0, 8, scr, r, F.lane); continue; } r -= I_C1;
            p0_transpose_item(a.in[9], 256, 1 << 30, 0, (bf16_t*)(ws + WS_WTC1V), 2048, 0, 8, scr, r, F.lane);
        }
    }
    {
        const int gt = F.vcu * NTHREADS + F.tid, NGT = F.G * NTHREADS;
        float* rope = (float*)(ws + WS_ROPE);
        for (int id = gt; id < S_ * 8; id += NGT) {
            const int pos = id >> 3, i = id & 7;
            const float inv = (float)pow(500000.0, -(double)i / 8.0);
            const float ang = (float)pos * inv;
            const double rev = (double)ang * 0.15915494309189535;
            const double fr = rev - floor(rev);
            const float aa = (float)(fr * 6.283185307179586);
            rope[pos * 16 + i] = __cosf(aa); rope[pos * 16 + 8 + i] = __sinf(aa);
        }
        bf16_t* sk = (bf16_t*)(ws + WS_SUBK); const float* subkeys = a.in[18];
        for (int id = gt; id < 2 * 128 * 64; id += NGT) { const int c = id >> 13, n = (id >> 6) & 127, d = id & 63; sk[(size_t)c * 8192 + (d >> 3) * 1024 + n * 8 + (d & 7)] = f2bf(subkeys[id]); }
        const int task = F.NGW - 1 - F.gw;
        if (task < 256) { const int which = task >> 7, kc = (task >> 2) & 31, n = (task & 3) * 64 + F.lane; const float* pe = (which ? a.in[8] : a.in[5]) + kc * 64; const float* w1 = (which ? a.in[9] : a.in[6]) + (size_t)kc * 64 * 256 + n;
            float s0 = 0.f, s1 = 0.f, s2 = 0.f, s3 = 0.f;
#pragma unroll
            for (int k = 0; k < 64; k += 4) { s0 += pe[k] * w1[(size_t)k * 256]; s1 += pe[k + 1] * w1[(size_t)(k + 1) * 256]; s2 += pe[k + 2] * w1[(size_t)(k + 2) * 256]; s3 += pe[k + 3] * w1[(size_t)(k + 3) * 256]; }
            ((float*)(ws + WS_BIAS1))[(which * 32 + kc) * 256 + n] = (s0 + s1) + (s2 + s3); }
        { float* gt_ = (float*)(ws + WS_GAINS); for (int id = gt; id < 640; id += NGT) gt_[id] = (id < 64) ? a.in[3][id] : (id < 256) ? a.in[4][id - 64] : (id < 448) ? a.in[11][id - 256] : a.in[12][id - 448]; }
        bf16_t* w2t = (bf16_t*)(ws + WS_W2T);
        for (int id = gt; id < 2 * 64 * 256; id += NGT) { const int which = id >> 14, d = (id >> 8) & 63, n = id & 255; w2t[id] = f2bf((which ? a.in[10] : a.in[7])[n * 64 + d]); }
    }
    {
        const int gt = F.vcu * NTHREADS + F.tid, NGT = F.G * NTHREADS;
        fp4_table<true>((const f32x4*)a.in[19], (const f32x4*)a.in[16], ws + WS_U, peer::SU, gt, NGT);
        fp4_table<false>((const f32x4*)a.in[20], (const f32x4*)a.in[16], ws + WS_U + 16 * MiB, peer::SV, gt, NGT);
    }
    {
        const int gt = F.vcu * NTHREADS + F.tid, NGT = F.G * NTHREADS; bf16_t* wgt = (bf16_t*)(ws + WS_WG);
        for (int id = gt; id < 32 * 1024; id += NGT) { const int c = id >> 10, k = id & 1023; wgt[id] = (c < 24) ? f2bf(w_in[(size_t)k * IN_COLS + 1280 + c]) : (bf16_t)0; }
    }
    norm_rows4(x, g1, (bf16_t*)(ws + WS_H), F.gw, F.NGW, F.lane);
}


__device__ __forceinline__ void phase2(const Args& a, LAS unsigned char* lds, int vcu, int G, int wave, int lane) {
    unsigned char* ws = a.ws;
    const bf16_t* KV6 = (const bf16_t*)(ws + WS_KV6);
    const int fr = lane & 15, fq = lane >> 4;
    for (int tp = vcu; tp < 256; tp += G) { const int t2 = tp * 2 + (wave >> 2);
        const int which = t2 >> 8, t = t2 & 255, r0 = (t >> 2) * 64, c0 = (t & 3) * 64, bg = r0 >> 8, i0 = r0 & 255, kq = wave & 3;
        const bf16_t* A = KV6 + (size_t)which * KV6_STRIDE + ((size_t)bg * S_ + 16 * i0) * HD + 512 * kq;
        const bf16_t* Bt = (const bf16_t*)(ws + (which ? WS_WTC1V : WS_WTC1K)) + (size_t)c0 * 2048 + 512 * kq;
        const float* bp1 = (const float*)(ws + WS_BIAS1) + which * 32 * 256 + c0 + fr; bf16_t* HID = (bf16_t*)(ws + WS_HID) + (size_t)which * 4096 * 256;
        float bsum[4] = {0.f, 0.f, 0.f, 0.f};
#pragma unroll
        for (int kc = 0; kc < 32; ++kc) {
#pragma unroll
            for (int ni = 0; ni < 4; ++ni) bsum[ni] += bp1[kc * 256 + 16 * ni]; }
        f32x4 acc[4][4]; ZERO_ACC(acc);
        wave_gemm64(A, 1024, Bt, 2048, 512, acc, lane);
        __syncthreads();
        LAS float* mine = (LAS float*)(lds + wave * 16384) + lane;
#pragma unroll
        for (int mi = 0; mi < 4; ++mi)
#pragma unroll
            for (int ni = 0; ni < 4; ++ni)
#pragma unroll
                for (int j = 0; j < 4; ++j) mine[((mi * 4 + ni) * 4 + j) * 64] = acc[mi][ni][j];
        __syncthreads();
        const LAS float* grp = (const LAS float*)(lds + (wave & 4) * 16384) + lane;
#pragma unroll
        for (int ni = 0; ni < 4; ++ni)
#pragma unroll
            for (int j = 0; j < 4; ++j) { const int e = ((kq * 4 + ni) * 4 + j) * 64;
                const float v = (grp[e] + grp[e + 4096]) + (grp[e + 8192] + grp[e + 12288]);
                const int row = r0 + 16 * kq + 4 * fq + j, col = c0 + 16 * ni + fr;
                HID[(size_t)row * 256 + col] = f2bf(gelu_tanh(v + bsum[ni])); }
    }
    {
        const bf16_t* H = (const bf16_t*)(ws + WS_H); const bf16_t* WG = (const bf16_t*)(ws + WS_WG); float* gates = (float*)(ws + WS_GATES);
        for (int tile = vcu * 8 + wave; tile < T_ / 16; tile += G * 8) {
            const bf16_t* ap = WG + (size_t)fr * 1024 + fq * 8; const bf16_t* bp = H + (size_t)(tile * 16 + fr) * 1024 + fq * 8;
            f32x4 c0 = {0.f, 0.f, 0.f, 0.f}, c1 = c0;
#pragma unroll 8
            for (int ks = 0; ks < 32; ++ks) { const bf16x8 b = *(const bf16x8*)(bp + ks * 32);
                c0 = __builtin_amdgcn_mfma_f32_16x16x32_bf16(*(const bf16x8*)(ap + ks * 32), b, c0, 0, 0, 0);
                c1 = __builtin_amdgcn_mfma_f32_16x16x32_bf16(*(const bf16x8*)(ap + 16 * 1024 + ks * 32), b, c1, 0, 0, 0); }
            float* gp = gates + (size_t)(tile * 16 + fr) * 24 + 4 * fq;
#pragma unroll
            for (int j = 0; j < 4; ++j) { gp[j] = sigmoidf_(c0[j]); if (fq < 2) gp[16 + j] = sigmoidf_(c1[j]); }
        }
    }
}
__device__ __forceinline__ void cmp2_tasks(const Args& a, int gw, int NGW, int lane) {
    unsigned char* ws = a.ws; const float* rope = (const float*)(ws + WS_ROPE); const float* nsa_kn = a.in[4];
    const int fr = lane & 15;
    for (int id = gw; id < 128; id += NGW) {
        const int which = id >> 6, r0 = (id & 63) * 64;
        f32x4 acc[4][4]; ZERO_ACC(acc);
        wave_gemm64((const bf16_t*)(ws + WS_HID) + ((size_t)which * 4096 + r0) * 256, 256, (const bf16_t*)(ws + WS_W2T) + (size_t)which * 64 * 256, 256, 256, acc, lane);
        if (which == 1) {
            bf16_t* VC = (bf16_t*)(ws + WS_VCMP);
            FOR_ACC(acc, r0, 0, lane, VC[(size_t)row * 64 + col] = ((row & 255) < NCMP) ? f2bf(val) : (bf16_t)0; )
        } else {
            bf16_t* KC = (bf16_t*)(ws + WS_KCMP);
#pragma unroll
            for (int mi = 0; mi < 4; ++mi)
#pragma unroll
                for (int j = 0; j < 4; ++j) {
                    const int row = r0 + 16 * mi + 4 * (lane >> 4) + j, i = row & 255;
                    float ss = acc[mi][0][j] * acc[mi][0][j] + acc[mi][1][j] * acc[mi][1][j] + acc[mi][2][j] * acc[mi][2][j] + acc[mi][3][j] * acc[mi][3][j];
                    ss += __shfl_xor(ss, 1); ss += __shfl_xor(ss, 2); ss += __shfl_xor(ss, 4); ss += __shfl_xor(ss, 8);
                    const float rstd = rsqrtf(ss * (1.f / 64.f) + EPS);
                    float z[4];
#pragma unroll
                    for (int ni = 0; ni < 4; ++ni) z[ni] = acc[mi][ni][j] * rstd * nsa_kn[16 * ni + fr];
                    const float pz = __shfl_xor(z[0], 8); const int pos = (16 * i + 31) & 4095;
                    const float c = rope[pos * 16 + (fr & 7)], sn = rope[pos * 16 + 8 + (fr & 7)];
                    z[0] = (fr < 8) ? (z[0] * c - pz * sn) : (pz * sn + z[0] * c);
#pragma unroll
                    for (int ni = 0; ni < 4; ++ni) KC[(size_t)row * 64 + 16 * ni + fr] = (i < NCMP) ? f2bf(z[ni]) : (bf16_t)0;
                }
        }
    }
}
__device__ __forceinline__ void dil_combine(const Args& a, int gt, int NGT) {
    unsigned char* ws = a.ws; const bf16_t* DILO = (const bf16_t*)(ws + WS_DILO); const float* DLSE = (const float*)(ws + WS_DLSE); bf16_t* Y = (bf16_t*)(ws + WS_Y);
    for (int idx = gt; idx < T_ * 32; idx += NGT) {
        const int t = idx >> 5, c = idx & 31, h = c >> 3;
        const float l0 = DLSE[((size_t)0 * T_ + t) * 4 + h], l1 = DLSE[((size_t)1 * T_ + t) * 4 + h], l2 = DLSE[((size_t)2 * T_ + t) * 4 + h];
        const float mx = fmaxf(l0, fmaxf(l1, l2)); float w0 = __builtin_amdgcn_exp2f(l0 - mx), w1 = __builtin_amdgcn_exp2f(l1 - mx), w2 = __builtin_amdgcn_exp2f(l2 - mx);
        const float inv = 1.f / (w0 + w1 + w2); w0 *= inv; w1 *= inv; w2 *= inv;
        const u32x4 o0 = *(const u32x4*)(DILO + ((size_t)0 * T_ + t) * 256 + c * 8), o1 = *(const u32x4*)(DILO + ((size_t)1 * T_ + t) * 256 + c * 8), o2 = *(const u32x4*)(DILO + ((size_t)2 * T_ + t) * 256 + c * 8);
        u32x4 o;
#pragma unroll
        for (int i = 0; i < 4; ++i) {
            const float lo = w0 * __uint_as_float(o0[i] << 16) + w1 * __uint_as_float(o1[i] << 16) + w2 * __uint_as_float(o2[i] << 16);
            const float hi = w0 * __uint_as_float(o0[i] & 0xffff0000u) + w1 * __uint_as_float(o1[i] & 0xffff0000u) + w2 * __uint_as_float(o2[i] & 0xffff0000u);
            o[i] = pk2(lo, hi); }
        *(u32x4*)(Y + (size_t)t * YP + 512 + c * 8) = o;
    }
}
__device__ __forceinline__ void phase7(const Args& a, int gw, int NGW, int lane) { norm_rows4(a.out, a.in[16], (bf16_t*)(a.ws + WS_HN), gw, NGW, lane); }

__global__ void __launch_bounds__(NTHREADS, 2) mega_fwd(Args a) {
    extern __shared__ __attribute__((aligned(16))) unsigned char lds_raw[];
    Frame F;
    F.lds = (LAS unsigned char*)lds_raw;
    F.tid = threadIdx.x; F.lane = F.tid & 63; F.wave = __builtin_amdgcn_readfirstlane(F.tid >> 6);
    F.G = gridDim.x; { const int bx = blockIdx.x; F.vcu = (F.G % 8 == 0) ? (bx % 8) * (F.G / 8) + bx / 8 : bx; }
    F.gw = F.vcu * NWAVES + F.wave; F.NGW = F.G * NWAVES;
    unsigned char* ws = a.ws;
    const int lo = a.ph_lo, hi = a.ph_hi;
#ifndef PHASE_MASK
#define PHASE_MASK 0x7ff
#endif
#define IN(k) (((PHASE_MASK >> (k)) & 1) && lo <= (k) && (k) < hi)
    volatile LAS unsigned* MISC = (volatile LAS unsigned*)(F.lds + MISC_OFF);
    if (F.tid < 16) MISC[F.tid] = 0u;
    unsigned* barw = (unsigned*)(ws + WS_CTL);
    if (IN(0) && blockIdx.x == 0) { for (int i = F.tid; i < XCD_BAR_WORDS; i += NTHREADS) __hip_atomic_store(barw + i, 0u, RLX_AGENT); }
    __syncthreads();
    XcdBarrier bar; bar.bar = barw; bar.x = 0; bar.st = MISC;
#define SEAM(k) do { if (IN(k) && IN((k) + 1)) { if ((k) == 0) { cg::this_grid().sync(); bar = xcd_barrier_post(barw, MISC); } else xcd_barrier(bar); } } while (0)

#define DUPQ(k) ((DUP_MASK >> (k)) & 1)
#define RUN(k, ...) do { if (IN(k)) { __VA_ARGS__ if constexpr (DUPQ(k)) { xcd_barrier(bar); __VA_ARGS__ } } } while (0)
    if (IN(0)) { phase0(F, a); if constexpr (DUPQ(0)) { __syncthreads(); phase0(F, a); } } SEAM(0);
#define P1_BODY { pg8::Gemm g{(const bf16_t*)(ws + WS_H), (const bf16_t*)(ws + WS_WTIN), T_, NIN, D_}; pg8::StaticOrder S; S.init(T_, NIN, F.G, (int)blockIdx.x); \
        pg8::EpiInproj E{ws, (bf16_t*)a.out, -1, (LAS float*)(F.lds + RING_BYTES)}; \
        pg8::gemm_phase<pg8::EpiInproj, pg8::StaticOrder, true, true>(F.lds, g, S, E); }
    RUN(1, P1_BODY); SEAM(1);
    RUN(2, phase2(a, F.lds, F.vcu, F.G, F.wave, F.lane); ); SEAM(2);
    RUN(3,
        cmp2_tasks(a, F.gw, F.NGW, F.lane);
        for (int uid = F.vcu; uid < 1536; uid += F.G) { const int sub = uid & 15, h = (uid >> 4) & 3, bg = uid >> 6, g = bg % 3, b = bg / 3;
            const int res = (g == 0) ? 0 : (g == 1 ? (sub & 3) : sub), lb = (g == 0) ? sub : (g == 1 ? (sub >> 2) : 0);
            att::dil_unit(F.lds, b, g, h, res, lb, (const bf16_t*)(ws + WS_DIL), (bf16_t*)(ws + WS_DILO), (float*)(ws + WS_DLSE), F.wave, F.lane); } ); SEAM(3);
    RUN(4,
        dil_combine(a, F.vcu * NTHREADS + F.tid, F.G * NTHREADS);
        for (int i = F.vcu; i < 1024; i += F.G) { const int k = i >> 8, v = i & 255, bgi = v >> 4, s = v & 15;
            const int n = (k == 0) ? s : (k == 1) ? 63 - s : (k == 2) ? 16 + s : 47 - s;
            att::nsa_unit(F.lds, bgi >> 1, bgi & 1, n, (const bf16_t*)(ws + WS_QN), (const bf16_t*)(ws + WS_KV6), (const bf16_t*)(ws + WS_KCMP), (const bf16_t*)(ws + WS_VCMP), (const float*)(ws + WS_GATES), (bf16_t*)(ws + WS_Y), F.wave, F.lane); } ); SEAM(4);
    RUN(5, { pg8::Gemm g{(const bf16_t*)(ws + WS_Y), (const bf16_t*)(ws + WS_WTCAT), T_, D_, YP}; pg8::StaticOrder S; S.init(T_, D_, F.G, (int)blockIdx.x);
        pg8::EpiMerge E{(const bf16_t*)a.out, (bf16_t*)(ws + WS_MERGED), 8};
        pg8::gemm_phase<pg8::EpiMerge, pg8::StaticOrder, true, true>(F.lds, g, S, E); } ); SEAM(5);
    RUN(6, { pg8::Gemm g{(const bf16_t*)(ws + WS_MERGED), (const bf16_t*)(ws + WS_WTO), T_, D_, D_}; pg8::StaticOrder S; S.init(T_, D_, F.G, (int)blockIdx.x);
        pg8::EpiWo E{a.in[0], a.out, -1, (bf16_t*)(ws + WS_HN), (float*)(ws + WS_SSQ)};
        pg8::gemm_phase<pg8::EpiWo, pg8::StaticOrder, true, true>(F.lds, g, S, E); } ); SEAM(6);
    RUN(8, { pg8::Gemm g{(const bf16_t*)(ws + WS_HN), (const bf16_t*)(ws + WS_WTQ), T_, D_, D_}; pg8::StaticOrder S; S.init(T_, D_, F.G, (int)blockIdx.x);
        pg8::EpiPQ E{(bf16_t*)(ws + WS_PQ), (const float*)(ws + WS_SSQ), -1};
        pg8::gemm_phase<pg8::EpiPQ, pg8::StaticOrder, true, true>(F.lds, g, S, E); } ); SEAM(8);
    RUN(9,
        { const u32x4* src = (const u32x4*)(ws + WS_SUBK); LAS u32x4* dst = (LAS u32x4*)F.lds; for (int i = F.tid; i < 2048; i += NTHREADS) dst[i] = src[i]; }
        __syncthreads();
        for (int u = F.gw; u < 4096; u += F.NGW) peer::route_unit(F.lds, (u >> 2) * 32, u & 3, (const bf16_t*)(ws + WS_PQ), (int*)(ws + WS_IDX), (float*)(ws + WS_GS), F.wave, F.lane); ); SEAM(9);
    if (IN(10)) {
        peer::expert_selector_table((LAS unsigned char*)(F.lds + 98304), F.tid);
        for (int t = F.gw; t + 3 * F.NGW < T_; t += 4 * F.NGW) {
            __syncthreads();
            peer::expert_mfma4(t, t + F.NGW, t + 2 * F.NGW, t + 3 * F.NGW, (const bf16_t*)(ws + WS_HN), (const unsigned char*)(ws + WS_U), (const unsigned char*)(ws + WS_U + 16 * MiB), (const int*)(ws + WS_IDX), (const float*)(ws + WS_GS), (const float*)(ws + WS_SSQ), a.out, F.lane,
                              (LAS unsigned char*)(F.lds + 8192 + F.wave * 2048), (const LAS unsigned char*)(F.lds + 98304), (LAS unsigned char*)(F.lds + 32768 + F.wave * 8192)); }
    }
#undef IN
#undef SEAM
}
#ifndef DUP_MASK
#define DUP_MASK 0
#endif
static int g_grid = 0;
static void launch_mega(const Args& base, int lo, int hi, hipStream_t stream) {
    Args a = base; a.ph_lo = lo; a.ph_hi = hi;
    if (hi - lo > 1) {
        void* args[] = {&a};
        hipError_t e = hipLaunchCooperativeKernel((const void*)mega_fwd, dim3(g_grid), dim3(NTHREADS), args, LDS_BYTES, stream);
        if (e != hipSuccess) fprintf(stderr, "cooperative launch failed: %s (grid %d)\n", hipGetErrorString(e), g_grid);
    } else {
        hipLaunchKernelGGL(mega_fwd, dim3(g_grid), dim3(NTHREADS), LDS_BYTES, stream, a);
    }
}
extern "C" void kernel_launch(void* const* d_in, const int* in_sizes, int n_in, void* d_out, int out_size, void* d_ws, size_t ws_size, hipStream_t stream) {
    if (n_in != 21 || ws_size < WS_END) { fprintf(stderr, "kernel_launch: unexpected n_in %d / ws_size %zu (need %zu)\n", n_in, ws_size, (size_t)WS_END); return; }
    if (g_grid == 0) {
        int dev = 0, cus = 0, per_cu = 0;
        (void)hipGetDevice(&dev); (void)hipDeviceGetAttribute(&cus, hipDeviceAttributeMultiprocessorCount, dev);
        (void)hipFuncSetAttribute((const void*)mega_fwd, hipFuncAttributeMaxDynamicSharedMemorySize, LDS_BYTES);
        (void)hipOccupancyMaxActiveBlocksPerMultiprocessor(&per_cu, (const void*)mega_fwd, NTHREADS, LDS_BYTES);
        if (per_cu < 1) fprintf(stderr, "kernel_launch: occupancy query says %d blocks/CU\n", per_cu);
        (void)hipGetLastError();
        g_grid = cus;
    }
    const float* nsa_qn = (const float*)d_in[3]; const float* nsa_kn = (const float*)d_in[4];
    const float* w2_k = (const float*)d_in[7]; const float* w2_v = (const float*)d_in[10];
    const float* dil_qn = (const float*)d_in[11]; const float* dil_kn = (const float*)d_in[12];
    const float* norm2_g = (const float*)d_in[16]; const float* subkeys = (const float*)d_in[18];
    unsigned char* ws = (unsigned char*)d_ws; float* out = (float*)d_out;
    bf16_t* WTC1K = (bf16_t*)(ws + WS_WTC1K); bf16_t* WTC1V = (bf16_t*)(ws + WS_WTC1V);
    float* ROPE = (float*)(ws + WS_ROPE); float* BIAS1 = (float*)(ws + WS_BIAS1); bf16_t* KCMP = (bf16_t*)(ws + WS_KCMP); bf16_t* VCMP = (bf16_t*)(ws + WS_VCMP);
    bf16_t* HID = (bf16_t*)(ws + WS_HID); float* GATES = (float*)(ws + WS_GATES);
    bf16_t* Y = (bf16_t*)(ws + WS_Y); bf16_t* HN = (bf16_t*)(ws + WS_HN);
    bf16_t* QN = (bf16_t*)(ws + WS_QN); bf16_t* KV6 = (bf16_t*)(ws + WS_KV6); bf16_t* DIL = (bf16_t*)(ws + WS_DIL);
    bf16_t* PQ = (bf16_t*)(ws + WS_PQ); int* IDX = (int*)(ws + WS_IDX); float* GS = (float*)(ws + WS_GS);
    Args a{};
    for (int i = 0; i < 21; ++i) a.in[i] = (const float*)d_in[i];
    a.out = out; a.ws = ws; a.dup = DUP_MASK;

    launch_mega(a, 0, NPH, stream);
}
```

```cpp
#include <hip/hip_runtime.h>
#include <hip/hip_cooperative_groups.h>
#include <cstdio>
#include <cstdint>
namespace cg = cooperative_groups;

typedef unsigned short bf16_t;
typedef short bf16x8 __attribute__((ext_vector_type(8)));
typedef float f32x4 __attribute__((ext_vector_type(4)));
typedef float f32x16 __attribute__((ext_vector_type(16)));
typedef unsigned u32x4 __attribute__((ext_vector_type(4)));
typedef unsigned u32x2 __attribute__((ext_vector_type(2)));
#define LAS __attribute__((address_space(3)))

constexpr int B_ = 8, S_ = 4096, D_ = 1024, T_ = B_ * S_;
constexpr int HD = 64;
constexpr int IN_COLS = 5656, NIN = 5632;
constexpr int NCMP = 255;
constexpr float C2 = 0.125f * 1.4426950408889634f;
constexpr float EPS = 1e-6f;
constexpr int YP = 768;

constexpr size_t MiB = 1u << 20;
constexpr size_t WS_CTL = 0;
constexpr size_t WS_WTIN = 1 * MiB;
constexpr size_t WS_WTCAT = 12 * MiB;
constexpr size_t WS_WTO = 14 * MiB;
constexpr size_t WS_WTQ = 16 * MiB;
constexpr size_t WS_WTC1K = 18 * MiB;
constexpr size_t WS_WTC1V = 19 * MiB;
constexpr size_t WS_MISC = 20 * MiB;
constexpr size_t WS_ROPE = WS_MISC;
constexpr size_t WS_BIAS1 = WS_MISC + 256 * 1024;
constexpr size_t WS_W2T = WS_MISC + 384 * 1024;
constexpr size_t WS_KCMP = WS_MISC + 512 * 1024;
constexpr size_t WS_VCMP = WS_MISC + 1024 * 1024;
constexpr size_t WS_SUBK = WS_MISC + 1536 * 1024;
constexpr size_t WS_WG = WS_MISC + 1600 * 1024;
constexpr size_t WS_GAINS = WS_MISC + 1700 * 1024;
constexpr size_t WS_HID = 22 * MiB;
constexpr size_t WS_GATES = 26 * MiB;
constexpr size_t WS_DLSE = 29 * MiB;
constexpr size_t WS_U = 32 * MiB;
constexpr size_t WS_H = 96 * MiB;
constexpr size_t WS_Y = WS_H;
constexpr size_t WS_HN = WS_H;
constexpr size_t WS_SSQ = 26 * MiB;
constexpr size_t WS_QN = 160 * MiB;
constexpr size_t WS_KV6 = 192 * MiB;
constexpr size_t WS_DIL = 241 * MiB;
constexpr size_t WS_DILO = 385 * MiB;
constexpr size_t WS_MERGED = WS_QN;
constexpr size_t WS_PQ = WS_DIL;
constexpr size_t WS_IDX = WS_DIL + 64 * MiB;
constexpr size_t WS_GS = WS_DIL + 80 * MiB;
constexpr size_t WS_END = 433 * MiB;
constexpr size_t KV6_STRIDE = (size_t)B_ * 2 * S_ * HD;
constexpr size_t DIL_STRIDE = (size_t)B_ * 4 * S_ * HD;

__device__ __forceinline__ float bf2f(bf16_t v) { return __uint_as_float(((unsigned)v) << 16); }
__device__ __forceinline__ bf16_t f2bf(float f) { unsigned u = __float_as_uint(f); return (bf16_t)((u + 0x7fffu + ((u >> 16) & 1u)) >> 16); }
__device__ __forceinline__ unsigned pk2(float lo, float hi) { return (unsigned)f2bf(lo) | ((unsigned)f2bf(hi) << 16); }
__device__ __forceinline__ float wave_sum(float v) {
#pragma unroll
    for (int o = 1; o < 64; o <<= 1) v += __shfl_xor(v, o);
    return v;
}
__device__ __forceinline__ float wave_max(float v) {
#pragma unroll
    for (int o = 1; o < 64; o <<= 1) v = fmaxf(v, __shfl_xor(v, o));
    return v;
}
__device__ __forceinline__ float gelu_tanh(float x) {
    const float u = 0.7978845608028654f * (x + 0.044715f * x * x * x);
    const float e = __expf(2.f * u);
    const float th = 1.f - 2.f / (e + 1.f);
    return 0.5f * x * (1.f + th);
}
__device__ __forceinline__ float sigmoidf_(float x) { return 1.f / (1.f + __expf(-x)); }

__device__ __forceinline__ void wave_gemm64(const bf16_t* __restrict__ A, size_t lda, const bf16_t* __restrict__ Bt, size_t ldb, int K, f32x4 (&acc)[4][4], int lane) {
    const int fr = lane & 15, fq = lane >> 4;
    const bf16_t* ap = A + (size_t)fr * lda + fq * 8; const bf16_t* bp = Bt + (size_t)fr * ldb + fq * 8;
    for (int k = 0; k < K; k += 128) {
        bf16x8 a[4][4], b[4][4];
#pragma unroll
        for (int kk = 0; kk < 4; ++kk)
#pragma unroll
            for (int i = 0; i < 4; ++i) { a[kk][i] = *(const bf16x8*)(ap + (size_t)(16 * i) * lda + k + 32 * kk); b[kk][i] = *(const bf16x8*)(bp + (size_t)(16 * i) * ldb + k + 32 * kk); }
#pragma unroll
        for (int kk = 0; kk < 4; ++kk)
#pragma unroll
            for (int mi = 0; mi < 4; ++mi)
#pragma unroll
                for (int ni = 0; ni < 4; ++ni) acc[mi][ni] = __builtin_amdgcn_mfma_f32_16x16x32_bf16(a[kk][mi], b[kk][ni], acc[mi][ni], 0, 0, 0);
    }
}
#define ZERO_ACC(acc) _Pragma("unroll") for (int _a = 0; _a < 4; ++_a) _Pragma("unroll") for (int _b = 0; _b < 4; ++_b) acc[_a][_b] = (f32x4){0.f, 0.f, 0.f, 0.f}
#define FOR_ACC(acc, r0, c0, lane, ...) _Pragma("unroll") for (int _mi = 0; _mi < 4; ++_mi) _Pragma("unroll") for (int _ni = 0; _ni < 4; ++_ni) _Pragma("unroll") for (int _j = 0; _j < 4; ++_j) { \
    const int row = (r0) + 16 * _mi + 4 * ((lane) >> 4) + _j, col = (c0) + 16 * _ni + ((lane) & 15); const float val = acc[_mi][_ni][_j]; __VA_ARGS__ }

namespace pg8 {
#define PG8_LAS __attribute__((address_space(3)))
typedef unsigned short bf16_t;
typedef short bf16x8 __attribute__((ext_vector_type(8)));
typedef float f32x4 __attribute__((ext_vector_type(4)));
typedef unsigned u32x4 __attribute__((ext_vector_type(4)));
constexpr int BM = 256, BK = 64, HALF = 128, HTB = HALF * BK * 2  , STAGE_BYTES = 8 * HTB, NXCD = 8, WGM = 8;

__host__ __device__ __forceinline__ int lds_byte(int r, int c) { const int st = (r >> 4) * 2 + (c >> 5), rr = r & 15, cc = c & 31, ob = rr * 64 + cc * 2; return st * 1024 + (ob ^ (((ob >> 9) & 1) << 5)); }
__host__ __device__ __forceinline__ void stage_rc(int b, int& R, int& C) { const int st = b / 1024, sb = b % 1024, swz = sb ^ (((sb >> 9) & 1) << 5); R = (st >> 1) * 16 + swz / 64; C = (st & 1) * 32 + (swz % 64) / 2; }
__host__ __device__ __forceinline__ int perm32(int rho) { const int n = rho >> 4, i = rho & 15; return 8 * (i >> 2) + 4 * n + (i & 3); }

struct Unit { int pm, pn; };
struct Gemm { const bf16_t* A; const bf16_t* Bt; int M, N, K; };

struct StaticOrder {
    int nM, nN, nwg, G, c;
    __host__ __device__ void init(int M, int N, int G_, int c_) { nM = M / BM; nN = N / BM; nwg = nM * nN; G = G_; c = c_; }
    __host__ __device__ bool next(int i, Unit& u) const {
        const long L = (long)i * G + c; if (L >= nwg) return false;
        int wgid = (int)L; { const int q = nwg / NXCD, r = nwg % NXCD, xcd = wgid % NXCD, off = wgid / NXCD; wgid = (xcd < r ? xcd * (q + 1) : r * (q + 1) + (xcd - r) * q) + off; }
        const int nig = WGM * nN, gid = wgid / nig, fm = gid * WGM, gsz = (nM - fm) < WGM ? (nM - fm) : WGM;
        u.pm = fm + ((wgid % nig) % gsz); u.pn = (wgid % nig) / gsz; return true;
    }
    __device__ __forceinline__ void a_ready(const Unit&) const {}
    __device__ __forceinline__ void done(const Unit&) const {}
};

__device__ __forceinline__ unsigned cvt_pk_bf16(float lo, float hi) { unsigned r; asm volatile("v_cvt_pk_bf16_f32 %0, %1, %2" : "=v"(r) : "v"(lo), "v"(hi)); return r; }
__device__ __forceinline__ u32x4 pack8(const f32x4 v0, const f32x4 v1) { u32x4 w; w.x = cvt_pk_bf16(v0[0], v0[1]); w.y = cvt_pk_bf16(v0[2], v0[3]); w.z = cvt_pk_bf16(v1[0], v1[1]); w.w = cvt_pk_bf16(v1[2], v1[3]); return w; }
__device__ __forceinline__ float bfl(unsigned w) { return __uint_as_float(w << 16); }
__device__ __forceinline__ float bfh(unsigned w) { return __uint_as_float(w & 0xffff0000u); }
__device__ __forceinline__ float sigm(float x) { return __builtin_amdgcn_rcpf(1.f + __builtin_amdgcn_exp2f(-1.4426950408889634f * x)); }

struct EpiInproj {
    static constexpr bool PERM = true, AFTER_DRAIN = false, HAS_MID = false;
    unsigned char* ws; bf16_t* MG; int mid_t; PG8_LAS float* X;
    __device__ __forceinline__ void mid(f32x4 (&)[2][2][4][2], const Unit&, int, int, int, int) const {}
    __device__ __forceinline__ void operator()(const f32x4 (&acc)[2][2][4][2], const Unit& u, int wr, int wc, int fr, int fq) const {
        asm volatile("" : "+v"(fr), "+v"(fq));
        const int pn = u.pn;
        bf16_t* const QN = (bf16_t*)(ws + WS_QN); bf16_t* const KV6 = (bf16_t*)(ws + WS_KV6); bf16_t* const DIL = (bf16_t*)(ws + WS_DIL);
        const float* const gains = (const float*)(ws + WS_GAINS); const float* const nsa_qn = gains; const float* const nsa_kn = gains + 64; const float* const dil_qn = gains + 256; const float* const dil_kn = gains + 448;
        const float* const rope = (const float*)(ws + WS_ROPE);
        bool nb0 = false, nb1 = false, sg = false; const float* gain = nsa_qn; float scale = 1.f;
        bf16_t* base0; bf16_t* base1; unsigned bstr, rstr; const unsigned dl = (unsigned)((wc & 1) * 32 + fq * 8); unsigned lane_off;
        if (pn < 2) { nb0 = nb1 = true; scale = C2; base0 = QN + pn * 256; base1 = base0 + HALF; bstr = 4096u * 512u; rstr = 512u; lane_off = (unsigned)(wc * 32 + fq * 8); }
        else if (pn < 5) { if (pn == 3) { nb0 = true; gain = nsa_kn + 64; } else if (pn == 4) { nb0 = true; gain = nsa_kn + 128; }
            base0 = KV6 + (size_t)((pn - 2) * 2) * KV6_STRIDE; base1 = base0 + KV6_STRIDE; bstr = 2u * S_ * HD; rstr = HD; lane_off = (unsigned)(wc >> 1) * (unsigned)(S_ * HD) + dl; }
        else if (pn < 14) { const int gw = pn - 5, g = gw / 3, which = gw - 3 * g; if (which == 0) { nb0 = nb1 = true; gain = dil_qn + g * 64; scale = C2; } else if (which == 1) { nb0 = nb1 = true; gain = dil_kn + g * 64; }
            base0 = DIL + (size_t)gw * DIL_STRIDE; base1 = base0 + (size_t)2 * S_ * HD; bstr = 4u * S_ * HD; rstr = HD; lane_off = (unsigned)(wc >> 1) * (unsigned)(S_ * HD) + dl; }
        else { sg = true; base0 = MG + (pn - 14) * 128; base1 = base0 + HALF / 2; bstr = 4096u * 1024u; rstr = 1024u; lane_off = (unsigned)(wc * 16 + fq * 4); }
        const bool anyn = nb0;
        if (anyn) {
#pragma unroll
            for (int ai = 0; ai < 2; ++ai)
#pragma unroll
                for (int m = 0; m < 4; ++m) { const int rl = ai * HALF + wr * 64 + m * 16 + fr;
#pragma unroll
                    for (int bj = 0; bj < 2; ++bj) { if (bj == 1 && !nb1) continue;
                        const f32x4 v0 = acc[ai][bj][m][0], v1 = acc[ai][bj][m][1];
                        float ss = (v0[0] * v0[0] + v0[1] * v0[1]) + (v0[2] * v0[2] + v0[3] * v0[3]) + (v1[0] * v1[0] + v1[1] * v1[1]) + (v1[2] * v1[2] + v1[3] * v1[3]);
                        ss += __shfl_xor(ss, 16); ss += __shfl_xor(ss, 32);
                        if (fq == 0) X[rl * 8 + bj * 4 + wc] = ss; } }
            asm volatile("s_waitcnt lgkmcnt(0)" ::: "memory"); __builtin_amdgcn_s_barrier(); asm volatile("" ::: "memory");
        }
        f32x4 g0 = {1.f, 1.f, 1.f, 1.f}, g1 = g0;
        if (anyn) { g0 = *(const f32x4*)(gain + dl) * scale; g1 = *(const f32x4*)(gain + dl + 4) * scale; }
        const bool ropew = anyn && ((wc & 1) == 0);
#pragma unroll
        for (int ai = 0; ai < 2; ++ai)
#pragma unroll
            for (int m = 0; m < 4; ++m) {
                const int rl = ai * HALF + wr * 64 + m * 16 + fr; const unsigned row = (unsigned)(u.pm * BM + rl); const unsigned s = row & 4095u;
                const unsigned off = (row >> 12) * bstr + s * rstr + lane_off;
                f32x4 c0 = {1.f, 1.f, 1.f, 1.f}, c1 = c0, s0 = {0.f, 0.f, 0.f, 0.f}, s1 = s0;
                if (ropew && fq < 2) { const float* rp = rope + s * 16; c0 = *(const f32x4*)rp; c1 = *(const f32x4*)(rp + 4); s0 = *(const f32x4*)(rp + 8); s1 = *(const f32x4*)(rp + 12); if (fq == 0) { s0 = -s0; s1 = -s1; } }
#pragma unroll
                for (int bj = 0; bj < 2; ++bj) {
                    f32x4 v0 = acc[ai][bj][m][0], v1 = acc[ai][bj][m][1];
                    const bool nrm = (bj == 0) ? nb0 : nb1;
                    if (nrm) {
                        const float tot = X[rl * 8 + bj * 4 + wc] + X[rl * 8 + bj * 4 + (wc ^ 1)];
                        const float rstd = __builtin_amdgcn_rsqf(tot * (1.f / 64.f) + EPS);
                        v0 = v0 * rstd * g0; v1 = v1 * rstd * g1;
                        if (ropew) {
#pragma unroll
                            for (int i = 0; i < 4; ++i) { const float p0 = __shfl_xor(v0[i], 16), p1 = __shfl_xor(v1[i], 16); v0[i] = v0[i] * c0[i] + p0 * s0[i]; v1[i] = v1[i] * c1[i] + p1 * s1[i]; }
                        }
                    }
                    if (sg) {
                        unsigned wx = 0u, wy = 0u;
#pragma unroll
                        for (int i = 0; i < 4; ++i) { wx = __builtin_amdgcn_cvt_pk_u8_f32(sigm(v0[i]) * 256.f - 0.5f, i, wx); }
#pragma unroll
                        for (int i = 0; i < 4; ++i) { wy = __builtin_amdgcn_cvt_pk_u8_f32(sigm(v1[i]) * 256.f - 0.5f, i, wy); }
                        bf16_t* const dp = (bj ? base1 : base0) + off; asm volatile("global_store_dwordx2 %0, %1, off" :: "v"(dp), "v"((u32x2){wx, wy}) : "memory"); }
                    else *(u32x4*)((bj ? base1 : base0) + off) = pack8(v0, v1);
                }
                asm volatile("" ::: "memory");
            }
    }
};
struct EpiMerge {
    static constexpr bool PERM = true, AFTER_DRAIN = false, HAS_MID = true;
    const unsigned char* MG8; bf16_t* MERGED; int mid_t;
    __device__ __forceinline__ void mid(f32x4 (&acc)[2][2][4][2], const Unit& u, int wr, int wc, int fr, int fq) const {
        asm volatile("" : "+v"(fr), "+v"(fq));
#pragma unroll
        for (int ai = 0; ai < 2; ++ai)
#pragma unroll
            for (int m = 0; m < 4; ++m) {
                const int row = u.pm * BM + ai * HALF + wr * 64 + m * 16 + fr;
#pragma unroll
                for (int bj = 0; bj < 2; ++bj) {
                    const int col = u.pn * BM + bj * HALF + wc * 32 + fq * 8;
                    const u32x2 a = *(const u32x2*)(MG8 + (size_t)row * 2048 + col), b = *(const u32x2*)(MG8 + (size_t)row * 2048 + 1024 + col);
#pragma unroll
                    for (int i = 0; i < 8; ++i) { const float qa = (float)((a[i >> 2] >> (8 * (i & 3))) & 255u) + 0.5f, qb = (float)((b[i >> 2] >> (8 * (i & 3))) & 255u) + 0.5f;
                        acc[ai][bj][m][i >> 2][i & 3] *= qa * __builtin_amdgcn_rcpf(qb); }
                }
            }
    }
    __device__ __forceinline__ void operator()(const f32x4 (&acc)[2][2][4][2], const Unit& u, int wr, int wc, int fr, int fq) const {
#pragma unroll
        for (int ai = 0; ai < 2; ++ai)
#pragma unroll
            for (int m = 0; m < 4; ++m) {
                const int row = u.pm * BM + ai * HALF + wr * 64 + m * 16 + fr;
#pragma unroll
                for (int bj = 0; bj < 2; ++bj) {
                    const int col = u.pn * BM + bj * HALF + wc * 32 + fq * 8;
                    const u32x2 b = *(const u32x2*)(MG8 + (size_t)row * 2048 + 1024 + col);
                    f32x4 v0 = acc[ai][bj][m][0], v1 = acc[ai][bj][m][1];
#pragma unroll
                    for (int i = 0; i < 4; ++i) { v0[i] *= ((float)((b[0] >> (8 * i)) & 255u) + 0.5f) * (1.f / 256.f); v1[i] *= ((float)((b[1] >> (8 * i)) & 255u) + 0.5f) * (1.f / 256.f); }
                    *(u32x4*)(MERGED + (size_t)row * 1024 + col) = pack8(v0, v1);
                }
            }
    }
};
struct EpiWo {
    static constexpr bool PERM = false, AFTER_DRAIN = false, HAS_MID = false;
    const float* x; float* out; int mid_t; bf16_t* X1B; float* SSQ;
    __device__ __forceinline__ void mid(f32x4 (&)[2][2][4][2], const Unit&, int, int, int, int) const {}
    __device__ __forceinline__ void operator()(const f32x4 (&acc)[2][2][4][2], const Unit& u, int wr, int wc, int fr, int fq) const {
        asm volatile("" : "+v"(fr), "+v"(fq));
#pragma unroll
        for (int ai = 0; ai < 2; ++ai)
#pragma unroll
            for (int m = 0; m < 4; ++m) {
                const int row = u.pm * BM + ai * HALF + wr * 64 + m * 16 + fr;
                const size_t off = (size_t)row * 1024 + u.pn * BM + wc * 32 + fq * 4;
                float ss = 0.f;
#pragma unroll
                for (int bj = 0; bj < 2; ++bj)
#pragma unroll
                    for (int n = 0; n < 2; ++n) { const f32x4 bs = *(const f32x4*)(x + off + bj * HALF + n * 16); const f32x4 v = bs + acc[ai][bj][m][n];
                        ss += (v[0] * v[0] + v[1] * v[1]) + (v[2] * v[2] + v[3] * v[3]);
                        u32x2 w; w.x = cvt_pk_bf16(v[0], v[1]); w.y = cvt_pk_bf16(v[2], v[3]); *(u32x2*)(X1B + off + bj * HALF + n * 16) = w; }
                ss += __shfl_xor(ss, 16); ss += __shfl_xor(ss, 32);
                if (fq == 0) SSQ[(size_t)row * 16 + u.pn * 4 + wc] = ss;
                asm volatile("" ::: "memory");
            }
    }
};
struct EpiPQ {
    static constexpr bool PERM = true, AFTER_DRAIN = false, HAS_MID = false;
    bf16_t* O; const float* SSQ; int mid_t;
    __device__ __forceinline__ void mid(f32x4 (&)[2][2][4][2], const Unit&, int, int, int, int) const {}
    __device__ __forceinline__ void operator()(const f32x4 (&acc)[2][2][4][2], const Unit& u, int wr, int wc, int fr, int fq) const {
        asm volatile("" : "+v"(fr), "+v"(fq));
#pragma unroll
        for (int ai = 0; ai < 2; ++ai)
#pragma unroll
            for (int m = 0; m < 4; ++m) {
                const int row = u.pm * BM + ai * HALF + wr * 64 + m * 16 + fr;
                const f32x4* sp = (const f32x4*)(SSQ + (size_t)row * 16); const f32x4 s4 = (sp[0] + sp[1]) + (sp[2] + sp[3]);
                const float rstd = __builtin_amdgcn_rsqf(((s4[0] + s4[1]) + (s4[2] + s4[3])) * (1.f / 1024.f) + EPS);
                bf16_t* rowp = O + (size_t)row * 1024 + u.pn * BM + wc * 32 + fq * 8;
#pragma unroll
                for (int bj = 0; bj < 2; ++bj) *(u32x4*)(rowp + bj * HALF) = pack8(acc[ai][bj][m][0] * rstd, acc[ai][bj][m][1] * rstd);
                asm volatile("" ::: "memory");
            }
    }
};
struct EpiPlain {
    static constexpr bool PERM = true, AFTER_DRAIN = false, HAS_MID = false;
    bf16_t* O; int ldc; int mid_t;
    __device__ __forceinline__ void mid(f32x4 (&)[2][2][4][2], const Unit&, int, int, int, int) const {}
    __device__ __forceinline__ void operator()(const f32x4 (&acc)[2][2][4][2], const Unit& u, int wr, int wc, int fr, int fq) const {
#pragma unroll
        for (int ai = 0; ai < 2; ++ai)
#pragma unroll
            for (int m = 0; m < 4; ++m) {
                bf16_t* rowp = O + (size_t)(u.pm * BM + ai * HALF + wr * 64 + m * 16 + fr) * ldc + u.pn * BM + wc * 32 + fq * 8;
#pragma unroll
                for (int bj = 0; bj < 2; ++bj) *(u32x4*)(rowp + bj * HALF) = pack8(acc[ai][bj][m][0], acc[ai][bj][m][1]);
            }
    }
};
template <class Epi, class Sched, bool ALIGN_EPI = false, bool SP2 = false>
__device__ __forceinline__ void gemm_phase(PG8_LAS unsigned char* lds, const Gemm g, const Sched& S, const Epi& E) {
    const int tid = threadIdx.x, wid = __builtin_amdgcn_readfirstlane(tid >> 6), lane = tid & 63, wr = wid >> 2, wc = wid & 3, fr = lane & 15, fq = lane >> 4;
    const int K = g.K, nt = K / BK;
    unsigned voffA[2], voffB[2];
#pragma unroll
    for (int i = 0; i < 2; ++i) { int R, C; stage_rc(tid * 16 + i * 8192, R, C); const int Rb = Epi::PERM ? ((R & ~31) + perm32(R & 31)) : R;
        voffA[i] = (unsigned)(R * K + C) * 2u; voffB[i] = (unsigned)(Rb * K + C) * 2u; }
    const size_t kstep = (size_t)(BK * 2);
    const size_t hstep = (size_t)HALF * K * 2;
    const size_t tstep = 2 * hstep;
    const unsigned ldsw = (unsigned)wid * 1024u;
    const int aoff = lds_byte(wr * 64 + fr, fq * 8), boff = lds_byte(wc * 32 + fr, fq * 8);
#define PG8_SA(b, h) (((b) * 2 + (h)) * HTB)
#define PG8_SB(b, h) ((4 + (b) * 2 + (h)) * HTB)
#define PG8_STAGE(bufoff, gbase, voff) do { _Pragma("unroll") for (int _i = 0; _i < 2; ++_i) \
        __builtin_amdgcn_global_load_lds((const unsigned*)((const char*)(gbase) + (voff)[_i]), (PG8_LAS unsigned*)(lds + (bufoff) + ldsw + _i * 8192), 16, 0, 0); } while (0)
#define PG8_LDA(dst, b, h) do { _Pragma("unroll") for (int m = 0; m < 4; ++m) _Pragma("unroll") for (int k = 0; k < 2; ++k) dst[m][k] = *(const PG8_LAS bf16x8*)(lds + PG8_SA(b, h) + aoff + m * 2048 + k * 1024); } while (0)
#define PG8_LDB(dst, b, h) do { _Pragma("unroll") for (int n = 0; n < 2; ++n) _Pragma("unroll") for (int k = 0; k < 2; ++k) dst[n][k] = *(const PG8_LAS bf16x8*)(lds + PG8_SB(b, h) + boff + n * 2048 + k * 1024); } while (0)
#define PG8_MMA(ai, bj, At, Bt) do { __builtin_amdgcn_s_setprio(1); _Pragma("unroll") for (int m = 0; m < 4; ++m) _Pragma("unroll") for (int n = 0; n < 2; ++n) _Pragma("unroll") for (int k = 0; k < 2; ++k) \
        acc[ai][bj][m][n] = __builtin_amdgcn_mfma_f32_16x16x32_bf16(Bt[n][k], At[m][k], acc[ai][bj][m][n], 0, 0, 0); __builtin_amdgcn_s_setprio(0); } while (0)
#define PG8_WAIT_V(n) asm volatile("s_waitcnt vmcnt(" #n ")" ::: "memory")
#define PG8_WAIT_L(n) asm volatile("s_waitcnt lgkmcnt(" #n ")" ::: "memory")
#define PG8_BAR __builtin_amdgcn_s_barrier()
#define PG8_SCHED __builtin_amdgcn_sched_barrier(0)
    Unit cur, nxt; int ui = 0;
    if (!S.next(0, cur)) return;
    f32x4 acc[2][2][4][2];
#pragma unroll
    for (int a = 0; a < 2; ++a)
#pragma unroll
        for (int b = 0; b < 2; ++b)
#pragma unroll
            for (int m = 0; m < 4; ++m)
#pragma unroll
                for (int n = 0; n < 2; ++n) acc[a][b][m][n] = (f32x4){0.f, 0.f, 0.f, 0.f};
    bf16x8 At[4][2], B0[2][2], B1[2][2];
    const char* cA = (const char*)g.A + (size_t)cur.pm * tstep; const char* cB = (const char*)g.Bt + (size_t)cur.pn * tstep;
    S.a_ready(cur);
    if constexpr (SP2) {
        PG8_STAGE(PG8_SB(0, 0), cB, voffB); PG8_STAGE(PG8_SB(0, 1), cB + hstep, voffB); PG8_STAGE(PG8_SA(0, 0), cA, voffA); PG8_STAGE(PG8_SA(0, 1), cA + hstep, voffA);
        if (wr == 1) PG8_BAR;
        PG8_WAIT_V(2); PG8_BAR;
        PG8_STAGE(PG8_SB(1, 0), cB + kstep, voffB); PG8_STAGE(PG8_SA(1, 0), cA + kstep, voffA); PG8_STAGE(PG8_SB(1, 1), cB + hstep + kstep, voffB);
        PG8_WAIT_V(6); PG8_BAR;
    } else {
        PG8_STAGE(PG8_SB(0, 0), cB, voffB); PG8_STAGE(PG8_SA(0, 0), cA, voffA); PG8_STAGE(PG8_SB(0, 1), cB + hstep, voffB); PG8_STAGE(PG8_SA(0, 1), cA + hstep, voffA);
        if (wr == 1) PG8_BAR;
        PG8_WAIT_V(4); PG8_BAR;
        PG8_STAGE(PG8_SB(1, 0), cB + kstep, voffB); PG8_STAGE(PG8_SA(1, 0), cA + kstep, voffA); PG8_STAGE(PG8_SB(1, 1), cB + hstep + kstep, voffB);
        PG8_WAIT_V(6); PG8_BAR;
    }
    for (;;) {
        const bool has_next = S.next(ui + 1, nxt);
        const char* nA = has_next ? (const char*)g.A + (size_t)nxt.pm * tstep : cA; const char* nB = has_next ? (const char*)g.Bt + (size_t)nxt.pn * tstep : cB;
        for (int t = 0; t < nt; t += 2) {
            if constexpr (Epi::HAS_MID) { if (t == E.mid_t) E.mid(acc, cur, wr, wc, fr, fq); }
            const bool last = (t == nt - 2);
            const char* a1 = cA + (size_t)(t + 1) * kstep;
            const char* a2 = last ? nA : cA + (size_t)(t + 2) * kstep; const char* b2 = last ? nB : cB + (size_t)(t + 2) * kstep;
            const char* a3 = a2 + kstep; const char* b3 = b2 + kstep;
            if (last && has_next) S.a_ready(nxt);
            if constexpr (SP2) {
            PG8_LDB(B0, 0, 0); PG8_LDB(B1, 0, 1); PG8_SCHED; PG8_LDA(At, 0, 0); PG8_STAGE(PG8_SA(1, 1), a1 + hstep, voffA);
            PG8_WAIT_V(8); PG8_WAIT_L(0); PG8_BAR; PG8_MMA(0, 0, At, B0); PG8_MMA(0, 1, At, B1); PG8_BAR; PG8_SCHED;
            PG8_LDA(At, 0, 1); PG8_STAGE(PG8_SB(0, 0), b2, voffB); PG8_STAGE(PG8_SB(0, 1), b2 + hstep, voffB); PG8_STAGE(PG8_SA(0, 0), a2, voffA);
            PG8_WAIT_V(8); PG8_WAIT_L(0); PG8_BAR; PG8_MMA(1, 0, At, B0); PG8_MMA(1, 1, At, B1); PG8_BAR; PG8_SCHED;
            PG8_LDB(B0, 1, 0); PG8_LDB(B1, 1, 1); PG8_SCHED; PG8_LDA(At, 1, 0); PG8_STAGE(PG8_SA(0, 1), a2 + hstep, voffA);
            PG8_WAIT_V(8); PG8_WAIT_L(0); PG8_BAR; PG8_MMA(0, 0, At, B0); PG8_MMA(0, 1, At, B1); PG8_BAR; PG8_SCHED;
            PG8_LDA(At, 1, 1); PG8_STAGE(PG8_SB(1, 0), b3, voffB); PG8_STAGE(PG8_SB(1, 1), b3 + hstep, voffB); PG8_STAGE(PG8_SA(1, 0), a3, voffA);
            PG8_WAIT_V(8); PG8_WAIT_L(0); PG8_BAR; PG8_MMA(1, 0, At, B0); PG8_MMA(1, 1, At, B1); PG8_BAR; PG8_SCHED;
            } else {
            PG8_LDB(B0, 0, 0); PG8_SCHED; PG8_LDA(At, 0, 0); PG8_STAGE(PG8_SA(1, 1), a1 + hstep, voffA);
            PG8_WAIT_L(8); PG8_BAR; PG8_WAIT_L(0); PG8_MMA(0, 0, At, B0); PG8_BAR; PG8_SCHED;
            PG8_LDB(B1, 0, 1); PG8_STAGE(PG8_SB(0, 0), b2, voffB);
            PG8_BAR; PG8_WAIT_L(0); PG8_MMA(0, 1, At, B1); PG8_BAR;
            PG8_LDA(At, 0, 1); PG8_STAGE(PG8_SA(0, 0), a2, voffA);
            PG8_BAR; PG8_WAIT_L(0); PG8_MMA(1, 0, At, B0); PG8_BAR; PG8_SCHED;
            PG8_STAGE(PG8_SB(0, 1), b2 + hstep, voffB);
            PG8_WAIT_V(6); PG8_BAR; PG8_MMA(1, 1, At, B1); PG8_BAR;
            PG8_LDB(B0, 1, 0); PG8_SCHED; PG8_LDA(At, 1, 0); PG8_STAGE(PG8_SA(0, 1), a2 + hstep, voffA);
            PG8_WAIT_L(8); PG8_BAR; PG8_WAIT_L(0); PG8_MMA(0, 0, At, B0); PG8_BAR; PG8_SCHED;
            PG8_LDB(B1, 1, 1); PG8_STAGE(PG8_SB(1, 0), b3, voffB);
            PG8_BAR; PG8_WAIT_L(0); PG8_MMA(0, 1, At, B1); PG8_BAR;
            PG8_LDA(At, 1, 1); PG8_STAGE(PG8_SA(1, 0), a3, voffA);
            PG8_BAR; PG8_WAIT_L(0); PG8_MMA(1, 0, At, B0); PG8_BAR; PG8_SCHED;
            PG8_STAGE(PG8_SB(1, 1), b3 + hstep, voffB);
            PG8_WAIT_V(6); PG8_BAR; PG8_MMA(1, 1, At, B1); PG8_BAR;
            }
        }
        if constexpr (ALIGN_EPI) { if (wr == 0) PG8_BAR; }
        if constexpr (!Epi::AFTER_DRAIN) { E(acc, cur, wr, wc, fr, fq); S.done(cur); }
        if (!has_next) break;
#pragma unroll
        for (int a = 0; a < 2; ++a)
#pragma unroll
            for (int b = 0; b < 2; ++b)
#pragma unroll
                for (int m = 0; m < 4; ++m)
#pragma unroll
                    for (int n = 0; n < 2; ++n) acc[a][b][m][n] = (f32x4){0.f, 0.f, 0.f, 0.f};
        cur = nxt; cA = nA; cB = nB; ++ui;
        if constexpr (ALIGN_EPI) { if (wr == 1) PG8_BAR; }
    }
    PG8_WAIT_V(0);
    if constexpr (!ALIGN_EPI) { if (wr == 0) PG8_BAR; }
    PG8_BAR;
    if constexpr (Epi::AFTER_DRAIN) { E.fused(acc, cur, wr, wc, fr, fq, lds, wid, lane); S.done(cur); }
#undef PG8_SA
#undef PG8_SB
#undef PG8_STAGE
#undef PG8_LDA
#undef PG8_LDB
#undef PG8_MMA
#undef PG8_WAIT_V
#undef PG8_WAIT_L
#undef PG8_BAR
#undef PG8_SCHED
}
}
namespace att {
typedef short s16x4 __attribute__((ext_vector_type(4)));
__device__ __forceinline__ int crow(int r, int hi) { return (r & 3) + 8 * (r >> 2) + 4 * hi; }
__device__ __forceinline__ float max3f(float a, float b, float c) { float r; asm("v_max3_f32 %0, %1, %2, %3" : "=v"(r) : "v"(a), "v"(b), "v"(c)); return r; }
typedef float f32x2_t __attribute__((ext_vector_type(2))); typedef __bf16 bf16x2_t __attribute__((ext_vector_type(2)));
__device__ __forceinline__ unsigned cvtpk(float lo, float hi) { f32x2_t v = {lo, hi}; bf16x2_t b = __builtin_convertvector(v, bf16x2_t); return __builtin_bit_cast(unsigned, b); }
__device__ __forceinline__ float ex2(float v) { return __builtin_amdgcn_exp2f(v); }
__device__ __forceinline__ float swap_add(float v) { auto rr = __builtin_amdgcn_permlane32_swap(__float_as_uint(v), __float_as_uint(v), false, false); return __uint_as_float(rr[0]) + __uint_as_float(rr[1]); }
__device__ __forceinline__ float swap_max(float v) { auto rr = __builtin_amdgcn_permlane32_swap(__float_as_uint(v), __float_as_uint(v), false, false); return fmaxf(__uint_as_float(rr[0]), __uint_as_float(rr[1])); }

__device__ __forceinline__ void dma_k(const bf16_t* Kt, size_t pitch, LAS unsigned char* kslot, int wid, int lane) {
    __builtin_amdgcn_global_load_lds((const unsigned*)(Kt + (size_t)lane * pitch + wid * 8), (LAS unsigned*)(kslot + wid * 1024), 16, 0, 0);
}
__device__ __forceinline__ void dma_v(const bf16_t* Vt, size_t pitch, LAS unsigned char* vslot, int wid, int lane) {
    __builtin_amdgcn_global_load_lds((const unsigned*)(Vt + (size_t)(16 * (wid & 3) + (lane >> 2)) * pitch + (wid >> 2) * 32 + (lane & 3) * 8), (LAS unsigned*)(vslot + wid * 1024), 16, 0, 0);
}
template <bool BIAS>
__device__ __forceinline__ void qkt(f32x16& p0, f32x16& p1, const LAS unsigned char* kslot, const bf16x8 (&qr)[4], float bias, int r32, int hi) {
    const LAS unsigned char* kb = kslot + hi * 1024 + r32 * 16;
    f32x16 c0;
#pragma unroll
    for (int i = 0; i < 16; ++i) c0[i] = BIAS ? bias : 0.f;
#pragma unroll
    for (int d0 = 0; d0 < 4; ++d0) {
        const bf16x8 b0 = *(const LAS bf16x8*)(kb + d0 * 2048), b1 = *(const LAS bf16x8*)(kb + d0 * 2048 + 512);
        if (d0 == 0) { p0 = __builtin_amdgcn_mfma_f32_32x32x16_bf16(b0, qr[0], c0, 0, 0, 0); p1 = __builtin_amdgcn_mfma_f32_32x32x16_bf16(b1, qr[0], c0, 0, 0, 0); }
        else { p0 = __builtin_amdgcn_mfma_f32_32x32x16_bf16(b0, qr[d0], p0, 0, 0, 0); p1 = __builtin_amdgcn_mfma_f32_32x32x16_bf16(b1, qr[d0], p1, 0, 0, 0); }
    }
    asm volatile("s_nop 15\n\ts_nop 7" : "+v"(p0), "+v"(p1));
}
template <int K> __device__ __forceinline__ float keep_le(float p, int lim, float alt) { float r; asm volatile("v_cmp_le_i32 vcc, %1, %2\n\tv_cndmask_b32 %0, %3, %4, vcc" : "=v"(r) : "n"(K), "v"(lim), "v"(alt), "v"(p) : "vcc"); return r; }
__device__ __forceinline__ void mask_le(f32x16& p0, f32x16& p1, int lim, int hi, float alt) {
    const int l0 = lim - 4 * hi;
#define ATT_M(r) p0[r] = keep_le<((r) & 3) + 8 * ((r) >> 2)>(p0[r], l0, alt); p1[r] = keep_le<((r) & 3) + 8 * ((r) >> 2) + 32>(p1[r], l0, alt);
    ATT_M(0) ATT_M(1) ATT_M(2) ATT_M(3) ATT_M(4) ATT_M(5) ATT_M(6) ATT_M(7) ATT_M(8) ATT_M(9) ATT_M(10) ATT_M(11) ATT_M(12) ATT_M(13) ATT_M(14) ATT_M(15)
#undef ATT_M
}
template <int K> __device__ __forceinline__ float keep_gt(float p, int lim, float alt) { float r; asm volatile("v_cmp_gt_i32 vcc, %1, %2\n\tv_cndmask_b32 %0, %3, %4, vcc" : "=v"(r) : "n"(K), "v"(lim), "v"(alt), "v"(p) : "vcc"); return r; }
__device__ __forceinline__ void mask_gt(f32x16& p0, f32x16& p1, int lim, int hi, float alt) {
    const int l0 = lim - 4 * hi;
#define ATT_M(r) p0[r] = keep_gt<((r) & 3) + 8 * ((r) >> 2)>(p0[r], l0, alt); p1[r] = keep_gt<((r) & 3) + 8 * ((r) >> 2) + 32>(p1[r], l0, alt);
    ATT_M(0) ATT_M(1) ATT_M(2) ATT_M(3) ATT_M(4) ATT_M(5) ATT_M(6) ATT_M(7) ATT_M(8) ATT_M(9) ATT_M(10) ATT_M(11) ATT_M(12) ATT_M(13) ATT_M(14) ATT_M(15)
#undef ATT_M
}
__device__ __forceinline__ float rowmax(const f32x16& p0, const f32x16& p1) {
    float a = max3f(p0[0], p0[1], p1[0]), b = max3f(p0[2], p0[3], p1[1]); a = max3f(a, p1[2], p1[3]);
#pragma unroll
    for (int r = 4; r < 16; r += 4) { a = max3f(a, p0[r], p0[r + 1]); b = max3f(b, p0[r + 2], p0[r + 3]); a = max3f(a, p1[r], p1[r + 1]); b = max3f(b, p1[r + 2], p1[r + 3]); }
    return swap_max(fmaxf(a, b));
}
__device__ __forceinline__ float rowsum32(const f32x16& p0, const f32x16& p1) {
    float a = 0.f, b = 0.f;
#pragma unroll
    for (int r = 0; r < 16; r += 2) { a += p0[r] + p1[r]; b += p0[r + 1] + p1[r + 1]; }
    return a + b;
}
template <bool LSUM>
__device__ __forceinline__ void pv(f32x16 (&o)[2], f32x16& lacc, unsigned vb, const f32x16& p0, const f32x16& p1) {
    u32x4 pw0, pw1, pw2, pw3;
    pw0 = (u32x4){cvtpk(p0[0], p0[1]), cvtpk(p0[2], p0[3]), cvtpk(p0[4], p0[5]), cvtpk(p0[6], p0[7])};
    pw1 = (u32x4){cvtpk(p0[8], p0[9]), cvtpk(p0[10], p0[11]), cvtpk(p0[12], p0[13]), cvtpk(p0[14], p0[15])};
    pw2 = (u32x4){cvtpk(p1[0], p1[1]), cvtpk(p1[2], p1[3]), cvtpk(p1[4], p1[5]), cvtpk(p1[6], p1[7])};
    pw3 = (u32x4){cvtpk(p1[8], p1[9]), cvtpk(p1[10], p1[11]), cvtpk(p1[12], p1[13]), cvtpk(p1[14], p1[15])};
    const bf16x8 pa0 = __builtin_bit_cast(bf16x8, pw0), pa1 = __builtin_bit_cast(bf16x8, pw1), pa2 = __builtin_bit_cast(bf16x8, pw2), pa3 = __builtin_bit_cast(bf16x8, pw3);
    if (LSUM) {
        const short one = (short)0x3F80; const bf16x8 ones = {one, one, one, one, one, one, one, one};
        lacc = __builtin_amdgcn_mfma_f32_32x32x16_bf16(pa0, ones, lacc, 0, 0, 0); lacc = __builtin_amdgcn_mfma_f32_32x32x16_bf16(pa1, ones, lacc, 0, 0, 0);
        lacc = __builtin_amdgcn_mfma_f32_32x32x16_bf16(pa2, ones, lacc, 0, 0, 0); lacc = __builtin_amdgcn_mfma_f32_32x32x16_bf16(pa3, ones, lacc, 0, 0, 0);
    }
#pragma unroll
    for (int d0 = 0; d0 < 2; ++d0) { s16x4 lo[4], hi[4];
#pragma unroll
        for (int ks = 0; ks < 4; ++ks) {
            asm volatile("ds_read_b64_tr_b16 %0,%1 offset:%c2" : "=&v"(lo[ks]) : "v"(vb), "i"(d0 * 4096 + ks * 1024) : "memory");
            asm volatile("ds_read_b64_tr_b16 %0,%1 offset:%c2" : "=&v"(hi[ks]) : "v"(vb), "i"(d0 * 4096 + ks * 1024 + 512) : "memory"); }
        asm volatile("s_waitcnt lgkmcnt(0)" ::: "memory"); __builtin_amdgcn_sched_barrier(0);
#define ATT_PK(k) (bf16x8){lo[k][0], lo[k][1], lo[k][2], lo[k][3], hi[k][0], hi[k][1], hi[k][2], hi[k][3]}
        o[d0] = __builtin_amdgcn_mfma_f32_32x32x16_bf16(pa0, ATT_PK(0), o[d0], 0, 0, 0);
        o[d0] = __builtin_amdgcn_mfma_f32_32x32x16_bf16(pa1, ATT_PK(1), o[d0], 0, 0, 0);
        o[d0] = __builtin_amdgcn_mfma_f32_32x32x16_bf16(pa2, ATT_PK(2), o[d0], 0, 0, 0);
        o[d0] = __builtin_amdgcn_mfma_f32_32x32x16_bf16(pa3, ATT_PK(3), o[d0], 0, 0, 0);
#undef ATT_PK
    }
}
__device__ __forceinline__ void lds_fadd(LAS float* p, float v) { (void)__hip_atomic_fetch_add(p, v, __ATOMIC_RELAXED, __HIP_MEMORY_SCOPE_WORKGROUP); }
__device__ __forceinline__ f32x16 splat16(float v) { f32x16 r;
#pragma unroll
    for (int i = 0; i < 16; ++i) r[i] = v;
    return r; }

struct Soft { float m; f32x16 o[2]; f32x16 lacc; };
__device__ __forceinline__ void soft_init(Soft& s) { s.m = 0.f; s.o[0] = splat16(0.f); s.o[1] = splat16(0.f); s.lacc = splat16(0.f); }
constexpr float SOFT_THR = 8.f;
template <bool FIRST>
__device__ __forceinline__ void soft_step(Soft& s, f32x16& p0, f32x16& p1, LAS float* wsf, int r32, int hi) {
    const float rm = rowmax(p0, p1);
    if (FIRST) {
        s.m = rm;
#pragma unroll
        for (int r = 0; r < 16; ++r) { p0[r] -= rm; p1[r] -= rm; }
    } else if (__any(rm > SOFT_THR)) {
        const float delta = (rm > SOFT_THR) ? rm : 0.f, f = ex2(-delta); s.m += delta;
        if (hi == 0) wsf[r32] = f;
        asm volatile("s_waitcnt lgkmcnt(0)" ::: "memory");
#pragma unroll
        for (int r = 0; r < 16; ++r) { const float fr = wsf[crow(r, hi)]; s.o[0][r] *= fr; s.o[1][r] *= fr; s.lacc[r] *= fr; p0[r] -= delta; p1[r] -= delta; }
        asm volatile("s_waitcnt lgkmcnt(0)" ::: "memory");
    }
#pragma unroll
    for (int r = 0; r < 16; ++r) { p0[r] = ex2(p0[r]); p1[r] = ex2(p1[r]); }
}
#define ATT_SYNC() do { asm volatile("s_waitcnt vmcnt(0) lgkmcnt(0)" ::: "memory"); __syncthreads(); } while (0)
#define ATT_RING_SYNC(N) do { asm volatile("s_waitcnt vmcnt(" #N ") lgkmcnt(0)" ::: "memory"); __builtin_amdgcn_s_barrier(); asm volatile("" ::: "memory"); } while (0)


typedef short v4i16_t __attribute__((ext_vector_type(4)));
__device__ __forceinline__ void kload8(bf16x8 (&kf)[8], const LAS unsigned char* kslot, int r32, int hi) {
    const LAS unsigned char* kb = kslot + hi * 1024 + r32 * 16;
#pragma unroll
    for (int d0 = 0; d0 < 4; ++d0) { kf[2 * d0] = *(const LAS bf16x8*)(kb + d0 * 2048); kf[2 * d0 + 1] = *(const LAS bf16x8*)(kb + d0 * 2048 + 512); }
}
template <bool BIAS>
__device__ __forceinline__ void qkt_reg(f32x16& p0, f32x16& p1, const bf16x8 (&kf)[8], const bf16x8 (&qr)[4], float bias) {
    f32x16 c0;
#pragma unroll
    for (int i = 0; i < 16; ++i) c0[i] = BIAS ? bias : 0.f;
#pragma unroll
    for (int d0 = 0; d0 < 4; ++d0) {
        if (d0 == 0) { p0 = __builtin_amdgcn_mfma_f32_32x32x16_bf16(kf[0], qr[0], c0, 0, 0, 0); p1 = __builtin_amdgcn_mfma_f32_32x32x16_bf16(kf[1], qr[0], c0, 0, 0, 0); }
        else { p0 = __builtin_amdgcn_mfma_f32_32x32x16_bf16(kf[2 * d0], qr[d0], p0, 0, 0, 0); p1 = __builtin_amdgcn_mfma_f32_32x32x16_bf16(kf[2 * d0 + 1], qr[d0], p1, 0, 0, 0); }
    }
    asm volatile("s_nop 15\n\ts_nop 7" : "+v"(p0), "+v"(p1));
}
__device__ __forceinline__ s16x4 vtr(const LAS unsigned char* p) { return __builtin_bit_cast(s16x4, __builtin_amdgcn_ds_read_tr16_b64_v4i16((LAS v4i16_t*)p)); }
__device__ __forceinline__ void vload8(s16x4 (&vf)[8], const LAS unsigned char* vp, int d0) {
#pragma unroll
    for (int ks = 0; ks < 4; ++ks) { vf[2 * ks] = vtr(vp + d0 * 4096 + ks * 1024); vf[2 * ks + 1] = vtr(vp + d0 * 4096 + ks * 1024 + 512); }
}
__device__ __forceinline__ void pv_reg(f32x16 (&o)[2], f32x16& lacc, s16x4 (&vf)[8], const LAS unsigned char* vp, const f32x16& p0, const f32x16& p1) {
    u32x4 pw0, pw1, pw2, pw3;
    pw0 = (u32x4){cvtpk(p0[0], p0[1]), cvtpk(p0[2], p0[3]), cvtpk(p0[4], p0[5]), cvtpk(p0[6], p0[7])};
    pw1 = (u32x4){cvtpk(p0[8], p0[9]), cvtpk(p0[10], p0[11]), cvtpk(p0[12], p0[13]), cvtpk(p0[14], p0[15])};
    pw2 = (u32x4){cvtpk(p1[0], p1[1]), cvtpk(p1[2], p1[3]), cvtpk(p1[4], p1[5]), cvtpk(p1[6], p1[7])};
    pw3 = (u32x4){cvtpk(p1[8], p1[9]), cvtpk(p1[10], p1[11]), cvtpk(p1[12], p1[13]), cvtpk(p1[14], p1[15])};
    const bf16x8 pa[4] = {__builtin_bit_cast(bf16x8, pw0), __builtin_bit_cast(bf16x8, pw1), __builtin_bit_cast(bf16x8, pw2), __builtin_bit_cast(bf16x8, pw3)};
#pragma unroll
    for (int ks = 0; ks < 4; ++ks) { const s16x4 lo = vf[2 * ks], hh = vf[2 * ks + 1]; const bf16x8 vv = {lo[0], lo[1], lo[2], lo[3], hh[0], hh[1], hh[2], hh[3]};
        o[0] = __builtin_amdgcn_mfma_f32_32x32x16_bf16(pa[ks], vv, o[0], 0, 0, 0); }
    __builtin_amdgcn_sched_barrier(0);
    vload8(vf, vp, 1);
    __builtin_amdgcn_sched_barrier(0);
    const short one = (short)0x3F80; const bf16x8 ones = {one, one, one, one, one, one, one, one};
#pragma unroll
    for (int ks = 0; ks < 4; ++ks) lacc = __builtin_amdgcn_mfma_f32_32x32x16_bf16(pa[ks], ones, lacc, 0, 0, 0);
#pragma unroll
    for (int ks = 0; ks < 4; ++ks) { const s16x4 lo = vf[2 * ks], hh = vf[2 * ks + 1]; const bf16x8 vv = {lo[0], lo[1], lo[2], lo[3], hh[0], hh[1], hh[2], hh[3]};
        o[1] = __builtin_amdgcn_mfma_f32_32x32x16_bf16(pa[ks], vv, o[1], 0, 0, 0); }
}
#define ATT_SB() __builtin_amdgcn_sched_barrier(0)

#ifndef NSA_REP_CMP
#define NSA_REP_CMP 1
#endif
#ifndef NSA_REP_SLT
#define NSA_REP_SLT 1
#endif
#ifndef NSA_REP_SEL
#define NSA_REP_SEL 1
#endif
#ifndef NSA_REP_WIN
#define NSA_REP_WIN 1
#endif
constexpr int NSA_LK = 0, NSA_LV = 32768, NSA_IMP = 65536, NSA_WSF = NSA_IMP + 4 * 64 * 65 * 4, NSA_SELM = NSA_WSF + 8 * 256, NSA_SV = NSA_SELM + 512, NSA_END = NSA_SV + 8 * 256;
static_assert(NSA_END <= 147456, "NSA LDS map");
__device__ __forceinline__ void acc_store(LAS float* accp, const f32x16 (&o)[2], const f32x16* lsum, LAS float* wsf, float gate, int r32, int hi, bool add, bf16_t* yb) {
    if (hi == 0) wsf[32 + r32] = gate;
    asm volatile("s_waitcnt lgkmcnt(0)" ::: "memory");
#pragma unroll
    for (int r = 0; r < 16; ++r) { float fr = wsf[32 + crow(r, hi)]; if (lsum) fr *= __builtin_amdgcn_rcpf((*lsum)[r]);
        float v0 = o[0][r] * fr, v1 = o[1][r] * fr;
        if (add) { v0 += accp[r * 64]; v1 += accp[(16 + r) * 64]; }
        if (yb) { const int q = crow(r, hi); yb[(size_t)q * YP] = f2bf(v0); yb[(size_t)q * YP + 32] = f2bf(v1); }
        else { accp[r * 64] = v0; accp[(16 + r) * 64] = v1; } }
    asm volatile("s_waitcnt lgkmcnt(0)" ::: "memory");
}
__device__ __forceinline__ void nsa_unit(LAS unsigned char* lds, int b, int g, int n, const bf16_t* QN, const bf16_t* KV6, const bf16_t* KCMP, const bf16_t* VCMP, const float* gates, bf16_t* Y, int wid, int lane) {
    const int r32 = lane & 31, hi = lane >> 5, j = wid & 3, th = wid >> 2, hh = g * 4 + j;
    const int tokl = 32 * th + r32;
    const int s_tok = 64 * n + tokl;
    const size_t trow = (size_t)b * S_ + s_tok;
    LAS float* wsf = (LAS float*)(lds + NSA_WSF + wid * 256);
    LAS float* imp = (LAS float*)(lds + NSA_IMP);
    LAS float* accp = (LAS float*)(lds + NSA_IMP + wid * 8192) + lane;
    const size_t bg = (size_t)(b * 2 + g);
    const unsigned vb = (unsigned)(uintptr_t)(lds + NSA_LV) + ((lane >> 4) & 1) * 32 + (lane & 3) * 8 + (4 * hi + ((lane & 15) >> 2)) * 64;
    bf16x8 qr[4];
#pragma unroll
    for (int d0 = 0; d0 < 4; ++d0) qr[d0] = *(const bf16x8*)(QN + trow * 512 + hh * 64 + d0 * 16 + hi * 8);
    const float NEGINF = -INFINITY;

    const int ntc = (4 * n + 2) / 64 + 1;
    const int cmax = (s_tok >= 31) ? min((s_tok - 31) >> 4, NCMP - 1) : -1;
    f32x16 oc[2];
    for (int rep_ = 0; rep_ < NSA_REP_CMP; ++rep_) {
    __syncthreads();
    {
        const bf16_t* kc = KCMP + bg * 256 * 64; const bf16_t* vc = VCMP + bg * 256 * 64;
        for (int ti = 0; ti < ntc; ++ti) { dma_k(kc + (size_t)ti * 64 * 64, 64, lds + NSA_LK + ti * 8192, wid, lane); dma_v(vc + (size_t)ti * 64 * 64, 64, lds + NSA_LV + ti * 8192, wid, lane); }
    }
    ATT_SYNC();
    {
        float m = -1e30f, l = 0.f;
        for (int ti = 0; ti < ntc; ++ti) {
            f32x16 p0, p1; qkt<false>(p0, p1, lds + NSA_LK + ti * 8192, qr, 0.f, r32, hi);
            mask_le(p0, p1, cmax - 64 * ti, hi, -1e30f);
            const float rm = rowmax(p0, p1); const float mn = fmaxf(m, rm);
            float sum = 0.f;
#pragma unroll
            for (int r = 0; r < 16; ++r) sum += ex2(p0[r] - mn) + ex2(p1[r] - mn);
            l = l * ex2(m - mn) + swap_add(sum); m = mn;
        }
        const float inv = (s_tok >= 31) ? 1.f / l : 0.f;
        oc[0] = splat16(0.f); oc[1] = splat16(0.f);
        LAS float* impj = imp + (j * 64 + tokl) * 65; float carry = 0.f;
        for (int ti = 0; ti < ntc; ++ti) {
            f32x16 p0, p1; qkt<false>(p0, p1, lds + NSA_LK + ti * 8192, qr, 0.f, r32, hi);
            mask_le(p0, p1, cmax - 64 * ti, hi, -1e30f);
#pragma unroll
            for (int r = 0; r < 16; ++r) { p0[r] = ex2(p0[r] - m) * inv; p1[r] = ex2(p1[r] - m) * inv; }
            {
                float av[8], bv[8];
#pragma unroll
                for (int G4 = 0; G4 < 4; ++G4) { bv[G4] = 0.5f * p0[4 * G4 + 3]; av[G4] = (p0[4 * G4] + p0[4 * G4 + 1]) + (p0[4 * G4 + 2] + bv[G4]); bv[4 + G4] = 0.5f * p1[4 * G4 + 3]; av[4 + G4] = (p1[4 * G4] + p1[4 * G4 + 1]) + (p1[4 * G4 + 2] + bv[4 + G4]); }
                float rv[8];
#pragma unroll
                for (int g8 = 0; g8 < 8; ++g8) { auto rr = __builtin_amdgcn_permlane32_swap(__float_as_uint(bv[g8]), __float_as_uint(bv[g8]), false, false); rv[g8] = __uint_as_float(hi ? rr[0] : rr[1]); }
#pragma unroll
                for (int g8 = 0; g8 < 8; ++g8) { const float inc = hi ? rv[g8] : (g8 ? rv[g8 - 1] : carry); impj[16 * ti + 2 * g8 + hi] = av[g8] + inc; }
                carry = rv[7];
            }
            pv<false>(oc, oc[0], vb + ti * 8192, p0, p1);
        }
    }
    ATT_SYNC();
    }
    const bf16_t* ks = KV6 + 2 * KV6_STRIDE + bg * S_ * HD; const bf16_t* vs = KV6 + 3 * KV6_STRIDE + bg * S_ * HD;
    dma_k(ks + (size_t)n * 64 * 64, 64, lds + NSA_LK, wid, lane); dma_v(vs + (size_t)n * 64 * 64, 64, lds + NSA_LV, wid, lane);
    {
        LAS unsigned long long* selm = (LAS unsigned long long*)(lds + NSA_SELM);
        const bool cand = (lane >= 1) && (lane <= n - 2);
        const unsigned long long candm = __ballot(cand);
        for (int rep_ = 0; rep_ < NSA_REP_SLT; ++rep_)
        for (int i = 0; i < 8; ++i) {
            const int tk = wid * 8 + i;
            const float v = ((imp[(0 * 64 + tk) * 65 + lane] + imp[(1 * 64 + tk) * 65 + lane]) + imp[(2 * 64 + tk) * 65 + lane]) + imp[(3 * 64 + tk) * 65 + lane];
            bool sel;
            if (n < 16) sel = (lane <= n);
            else {
                const unsigned key = __float_as_uint(v);
                unsigned T = 0u;
                for (int bit = 30; bit >= 0; --bit) { const unsigned Tt = T | (1u << bit); const unsigned long long ge = __ballot(key >= Tt) & candm; if (__builtin_popcountll(ge) >= 13) T = Tt; }
                const unsigned long long gtm = __ballot(key > T) & candm, eqm = __ballot(key == T) & candm;
                const int need = 13 - (int)__builtin_popcountll(gtm);
                const int eqrank = (int)__builtin_popcountll(eqm & ((1ull << lane) - 1ull));
                sel = (lane == 0) || (lane == n) || (lane == n - 1) || (cand && (key > T || (key == T && eqrank < need)));
            }
            const unsigned long long bal = __ballot(sel);
            if (lane == 0) selm[tk] = bal;
        }
    }
    ATT_SYNC();
    const unsigned long long myselm = ((LAS unsigned long long*)(lds + NSA_SELM))[tokl];
    acc_store(accp, oc, nullptr, wsf, gates[trow * 24 + hh * 3 + 0], r32, hi, false, nullptr);
    const LAS unsigned char* vpl = lds + NSA_LV + ((lane >> 4) & 1) * 32 + (lane & 3) * 8 + (4 * hi + ((lane & 15) >> 2)) * 64;
    bf16x8 kf[8]; s16x4 vf[8];
    {
        Soft ss;
        for (int rep_ = 0; rep_ < NSA_REP_SEL; ++rep_) {
        if (rep_) { ATT_SYNC(); dma_k(ks + (size_t)n * 64 * 64, 64, lds + NSA_LK, wid, lane); dma_v(vs + (size_t)n * 64 * 64, 64, lds + NSA_LV, wid, lane); ATT_SYNC(); }
        soft_init(ss);
        const int nt = n + 1;
        if (nt > 1) { dma_k(ks, 64, lds + NSA_LK + 8192, wid, lane); dma_v(vs, 64, lds + NSA_LV + 8192, wid, lane); }
        kload8(kf, lds + NSA_LK, r32, hi);
        int slot = 0;
        for (int i = 0; i < nt; ++i) {
            const int np = (i == 0) ? n : i - 1;
            const bool bit = (myselm >> np) & 1ull;
            f32x16 p0, p1;
            if (i == 0) qkt_reg<false>(p0, p1, kf, qr, 0.f); else qkt_reg<true>(p0, p1, kf, qr, bit ? -ss.m : NEGINF);
            ATT_SB(); vload8(vf, vpl + slot * 8192, 0); ATT_SB();
            if (i == 0) { mask_le(p0, p1, tokl, hi, NEGINF); soft_step<true>(ss, p0, p1, wsf, r32, hi); } else soft_step<false>(ss, p0, p1, wsf, r32, hi);
            const int s1 = (slot == 2) ? 0 : slot + 1;
            if (i + 1 < nt) {
                ATT_SB(); asm volatile("s_waitcnt vmcnt(0)" ::: "memory"); __builtin_amdgcn_s_barrier(); asm volatile("" ::: "memory");
                if (i + 2 < nt) { const int s2 = (slot == 0) ? 2 : slot - 1; dma_k(ks + (size_t)(i + 1) * 64 * 64, 64, lds + NSA_LK + s2 * 8192, wid, lane); dma_v(vs + (size_t)(i + 1) * 64 * 64, 64, lds + NSA_LV + s2 * 8192, wid, lane); }
                kload8(kf, lds + NSA_LK + s1 * 8192, r32, hi); ATT_SB();
            }
            pv_reg(ss.o, ss.lacc, vf, vpl + slot * 8192, p0, p1);
            slot = s1;
        }
        }
        acc_store(accp, ss.o, &ss.lacc, wsf, gates[trow * 24 + hh * 3 + 1], r32, hi, true, nullptr);
    }
    ATT_SYNC();
    {
        const bf16_t* kw = KV6 + 4 * KV6_STRIDE + bg * S_ * HD; const bf16_t* vw = KV6 + 5 * KV6_STRIDE + bg * S_ * HD;
        Soft sw;
        const int nt = (n >= 8) ? 9 : n + 1;
        for (int rep_ = 0; rep_ < NSA_REP_WIN; ++rep_) {
        if (rep_) ATT_SYNC();
        soft_init(sw);
        dma_k(kw + (size_t)n * 64 * 64, 64, lds + NSA_LK, wid, lane); dma_v(vw + (size_t)n * 64 * 64, 64, lds + NSA_LV, wid, lane);
        ATT_SYNC();
        if (nt > 1) { dma_k(kw + (size_t)(n - 1) * 64 * 64, 64, lds + NSA_LK + 8192, wid, lane); dma_v(vw + (size_t)(n - 1) * 64 * 64, 64, lds + NSA_LV + 8192, wid, lane); }
        kload8(kf, lds + NSA_LK, r32, hi);
        int slot = 0;
        for (int i = 0; i < nt; ++i) {
            f32x16 p0, p1;
            if (i == 0) qkt_reg<false>(p0, p1, kf, qr, 0.f); else qkt_reg<true>(p0, p1, kf, qr, -sw.m);
            ATT_SB(); vload8(vf, vpl + slot * 8192, 0); ATT_SB();
            if (i == 0) { mask_le(p0, p1, tokl, hi, NEGINF); soft_step<true>(sw, p0, p1, wsf, r32, hi); } else { if (i == 8) mask_gt(p0, p1, tokl, hi, NEGINF); soft_step<false>(sw, p0, p1, wsf, r32, hi); }
            const int s1 = (slot == 2) ? 0 : slot + 1;
            if (i + 1 < nt) {
                ATT_SB(); asm volatile("s_waitcnt vmcnt(0)" ::: "memory"); __builtin_amdgcn_s_barrier(); asm volatile("" ::: "memory");
                if (i + 2 < nt) { const int s2 = (slot == 0) ? 2 : slot - 1; const int nn = n - i - 2; dma_k(kw + (size_t)nn * 64 * 64, 64, lds + NSA_LK + s2 * 8192, wid, lane); dma_v(vw + (size_t)nn * 64 * 64, 64, lds + NSA_LV + s2 * 8192, wid, lane); }
                kload8(kf, lds + NSA_LK + s1 * 8192, r32, hi); ATT_SB();
            }
            pv_reg(sw.o, sw.lacc, vf, vpl + slot * 8192, p0, p1);
            slot = s1;
        }
        }
        acc_store(accp, sw.o, &sw.lacc, wsf, gates[trow * 24 + hh * 3 + 2], r32, hi, true, Y + ((size_t)b * S_ + 64 * n + 32 * th) * YP + hh * 64 + r32);
    }
}

constexpr int DL_LK = 0, DL_LV = 49152, DL_WSF = 98304;
__device__ __forceinline__ void dil_unit(LAS unsigned char* lds, int b, int g, int h, int res, int lb, const bf16_t* DIL, bf16_t* DILO, float* DLSE, int wid, int lane) {
    const int r32 = lane & 31, hi = lane >> 5;
    const int dil = (g == 0) ? 1 : (g == 1 ? 4 : 16);
    const size_t hb = ((size_t)(b * 4 + h) * S_) * HD;
    const bf16_t* Qb = DIL + (size_t)(g * 3 + 0) * DIL_STRIDE + hb; const bf16_t* Kb = DIL + (size_t)(g * 3 + 1) * DIL_STRIDE + hb; const bf16_t* Vb = DIL + (size_t)(g * 3 + 2) * DIL_STRIDE + hb;
    LAS float* wsf = (LAS float*)(lds + DL_WSF + wid * 256);
    const unsigned vb = (unsigned)(uintptr_t)(lds + DL_LV) + ((lane >> 4) & 1) * 32 + (lane & 3) * 8 + (4 * hi + ((lane & 15) >> 2)) * 64;
    const int L0 = 256 * lb - 128;
    __syncthreads();
    for (int ti = 0; ti < 6; ++ti) { const int Lr = L0 + 64 * ti; if (Lr < 0) continue;
        dma_k(Kb + (size_t)(res + dil * Lr) * HD, (size_t)dil * HD, lds + DL_LK + ti * 8192, wid, lane); dma_v(Vb + (size_t)(res + dil * Lr) * HD, (size_t)dil * HD, lds + DL_LV + ti * 8192, wid, lane); }
    const int Lq = 256 * lb + 32 * wid + r32;
    const size_t tq = (size_t)res + (size_t)dil * Lq;
    bf16x8 qr[4];
#pragma unroll
    for (int d0 = 0; d0 < 4; ++d0) qr[d0] = *(const bf16x8*)(Qb + tq * HD + d0 * 16 + hi * 8);
    ATT_SYNC();
    Soft ss; soft_init(ss);
    const int lim = 32 * (wid & 1) + r32;
    for (int k = 2; k >= 0; --k) {
        const int ti = (wid >> 1) + k;
        if (L0 + 64 * ti < 0) continue;
        f32x16 p0, p1;
        if (k == 2) { qkt<false>(p0, p1, lds + DL_LK + ti * 8192, qr, 0.f, r32, hi); mask_le(p0, p1, lim, hi, -INFINITY); soft_step<true>(ss, p0, p1, wsf, r32, hi); }
        else { qkt<true>(p0, p1, lds + DL_LK + ti * 8192, qr, -ss.m, r32, hi); if (k == 0) mask_gt(p0, p1, lim - 1, hi, -INFINITY); soft_step<false>(ss, p0, p1, wsf, r32, hi); }
        pv<true>(ss.o, ss.lacc, vb + ti * 8192, p0, p1);
    }
    if (r32 == 0) {
#pragma unroll
        for (int r = 0; r < 16; ++r) wsf[32 + crow(r, hi)] = ss.lacc[r]; }
    asm volatile("s_waitcnt lgkmcnt(0)" ::: "memory");
    if (hi == 0) DLSE[((size_t)g * T_ + (size_t)b * S_ + tq) * 4 + h] = ss.m + __builtin_amdgcn_logf(wsf[32 + r32]);
    bf16_t* ob = DILO + ((size_t)g * T_ + (size_t)b * S_ + res + (size_t)dil * (256 * lb + 32 * wid)) * 256 + h * 64 + r32;
#pragma unroll
    for (int r = 0; r < 16; ++r) { const int q = crow(r, hi); const float fr = __builtin_amdgcn_rcpf(ss.lacc[r]);
        ob[(size_t)q * dil * 256] = f2bf(ss.o[0][r] * fr); ob[(size_t)q * dil * 256 + 32] = f2bf(ss.o[1][r] * fr); }
    asm volatile("s_waitcnt lgkmcnt(0)" ::: "memory");
}
}
namespace peer {
using att::crow; using att::max3f; using att::swap_max;
constexpr int RT_TOPS = 32768, RT_TOPS_WAVE = 64 * 33 * 4;
__device__ __forceinline__ float drop_eq(float v, float M, float ninf) { float r; asm volatile("v_cmp_eq_f32 vcc, %1, %2\n\tv_cndmask_b32 %0, %2, %3, vcc" : "=v"(r) : "v"(M), "v"(v), "v"(ninf) : "vcc"); return r; }
__device__ __forceinline__ void cex(float& a, float& b) { const float hi_ = fmaxf(a, b), lo_ = fminf(a, b); a = hi_; b = lo_; }
__device__ __forceinline__ void bitonic_merge16(f32x16& v) {
#pragma unroll
    for (int j = 8; j >= 1; j >>= 1)
#pragma unroll
        for (int i = 0; i < 16; ++i) if ((i & j) == 0) { float a = v[i], b = v[i | j]; cex(a, b); v[i] = a; v[i | j] = b; }
}
__device__ __forceinline__ void sort16(f32x16& v) {
#pragma unroll
    for (int k = 2; k <= 16; k <<= 1)
#pragma unroll
        for (int j = k >> 1; j >= 1; j >>= 1)
#pragma unroll
            for (int i = 0; i < 16; ++i) { const int l = i ^ j; if (l > i) { float a = v[i], b = v[l]; const bool desc = ((i & k) == 0) || (k == 16); if (desc) cex(a, b); else cex(b, a); v[i] = a; v[l] = b; } }
}
__device__ __forceinline__ void merge_top16(f32x16& a, const f32x16& b) {
#pragma unroll
    for (int i = 0; i < 16; ++i) a[i] = fmaxf(a[i], b[15 - i]);
    bitonic_merge16(a);
}
__device__ __forceinline__ void route_unit(LAS unsigned char* lds, int tok0, int hp, const bf16_t* PQ, int* IDX, float* GS, int wid, int lane) {
    const int r32 = lane & 31, hi = lane >> 5;
    LAS float* tops = (LAS float*)(lds + RT_TOPS + wid * RT_TOPS_WAVE);
    const float NINF = -INFINITY; const unsigned hi4 = 4u * (unsigned)hi;
    bf16x8 qall[4][4];
#pragma unroll
    for (int rd = 0; rd < 4; ++rd)
#pragma unroll
        for (int d0 = 0; d0 < 4; ++d0) qall[rd][d0] = *(const bf16x8*)(PQ + (size_t)(tok0 + r32) * 1024 + (hp * 2 + (rd >> 1)) * 128 + (rd & 1) * 64 + d0 * 16 + hi * 8);
#pragma unroll
    for (int hl = 0; hl < 2; ++hl)
#pragma unroll
        for (int c = 0; c < 2; ++c) {
            const bf16x8 (&qr)[4] = qall[hl * 2 + c];
            f32x16 p[4];
            const LAS unsigned char* kbase = lds + c * 16384 + hi * 2048 + r32 * 16;
#pragma unroll
            for (int kb = 0; kb < 4; ++kb) {
                f32x16 z;
#pragma unroll
                for (int i = 0; i < 16; ++i) z[i] = 0.f;
#pragma unroll
                for (int d0 = 0; d0 < 4; ++d0) { const bf16x8 af = *(const LAS bf16x8*)(kbase + d0 * 4096 + kb * 512); p[kb] = __builtin_amdgcn_mfma_f32_32x32x16_bf16(af, qr[d0], d0 == 0 ? z : p[kb], 0, 0, 0); }
            }
            asm volatile("s_nop 15\n\ts_nop 7" : "+v"(p[0]), "+v"(p[1]), "+v"(p[2]), "+v"(p[3]));
#pragma unroll
            for (int kb = 0; kb < 4; ++kb)
#pragma unroll
                for (int r = 0; r < 16; ++r) { const unsigned K = 127u - 32u * kb - (unsigned)((r & 3) + 8 * (r >> 2)); p[kb][r] = __uint_as_float(((__float_as_uint(p[kb][r]) & 0xFFFFFF80u) | K) - hi4); }
            sort16(p[0]); sort16(p[1]); sort16(p[2]); sort16(p[3]);
            merge_top16(p[0], p[1]); merge_top16(p[2], p[3]); merge_top16(p[0], p[2]);
            {
                f32x16 q;
#pragma unroll
                for (int i = 0; i < 16; ++i) { auto rr = __builtin_amdgcn_permlane32_swap(__float_as_uint(p[0][i]), __float_as_uint(p[0][i]), false, false); q[i] = __uint_as_float(hi ? rr[0] : rr[1]); }
#pragma unroll
                for (int i = 0; i < 16; ++i) p[1][i] = fmaxf(p[0][i], q[15 - i]);
                bitonic_merge16(p[1]);
            }
            if (hi == 0) {
#pragma unroll
                for (int it = 0; it < 16; ++it) tops[(hl * 32 + r32) * 33 + c * 16 + it] = p[1][it]; }
        }
    asm volatile("s_waitcnt lgkmcnt(0)" ::: "memory");
    const LAS float* my = tops + lane * 33;
    float s1[16], s2[16];
#pragma unroll
    for (int k = 0; k < 16; ++k) { s1[k] = my[k]; s2[k] = my[16 + k]; }
    f32x16 cb[4];
    {
        int n = 0;
#pragma unroll
        for (int a = 0; a < 16; ++a)
#pragma unroll
            for (int b = 0; b < 16; ++b) if ((a + 1) * (b + 1) <= 16) { cb[n >> 4][n & 15] = __uint_as_float((__float_as_uint(s1[a] + s2[b]) & 0xFFFFFF00u) | (unsigned)(255 - (16 * a + b))); ++n; }
#pragma unroll
        for (int k = 50; k < 64; ++k) cb[k >> 4][k & 15] = NINF;
    }
    sort16(cb[0]); sort16(cb[1]); sort16(cb[2]); sort16(cb[3]);
    merge_top16(cb[0], cb[1]); merge_top16(cb[2], cb[3]); merge_top16(cb[0], cb[2]);
    float rk[16];
#pragma unroll
    for (int k = 0; k < 16; ++k) rk[k] = cb[0][k];
    float den = 0.f, ev[16];
#pragma unroll
    for (int k = 0; k < 16; ++k) { ev[k] = __expf(rk[k] - rk[0]); den += ev[k]; }
    const float inv = 1.f / den;
    const int t = tok0 + r32, h = hp * 2 + hi;
    int* ip = IDX + (size_t)t * 128 + h * 16; float* gp = GS + (size_t)t * 128 + h * 16;
#pragma unroll
    for (int k4 = 0; k4 < 4; ++k4) {
        u32x4 iv; f32x4 gv;
#pragma unroll
        for (int i = 0; i < 4; ++i) { const int k = k4 * 4 + i; const unsigned pid = 255u - (__float_as_uint(rk[k]) & 255u); const unsigned aa = pid >> 4, bb = pid & 15u;
            const unsigned i1 = 127u - (__float_as_uint(my[aa]) & 127u), i2 = 127u - (__float_as_uint(my[16 + bb]) & 127u); iv[i] = i1 * 128u + i2; gv[i] = ev[k] * inv; }
        *(u32x4*)(ip + k4 * 4) = iv; *(f32x4*)(gp + k4 * 4) = gv;
    }
    asm volatile("s_waitcnt lgkmcnt(0)" ::: "memory");
}

typedef float f32x2 __attribute__((ext_vector_type(2)));
constexpr float SU = 64.f, SV = 5.5f;
typedef unsigned u32x6 __attribute__((ext_vector_type(6)));
typedef float f32x32 __attribute__((ext_vector_type(32)));
constexpr int ROWB = 512;
constexpr int ROWBV = 512;
typedef __amdgpu_buffer_rsrc_t rsrc_t;
typedef int i32x8 __attribute__((ext_vector_type(8)));
template <int CTRL> __device__ __forceinline__ float dpp_mov(float x) { return __uint_as_float(__builtin_amdgcn_update_dpp(0, __float_as_uint(x), CTRL, 0xf, 0xf, false)); }
template <int EMASK> __device__ __forceinline__ void expert_lists(int X, int e_lo, int e_hi, float g_lo, float g_hi, int lane, LAS unsigned char* wl) {
    const int c_lo = (e_lo >> 3) & 15, c_hi = (e_hi >> 3) & 15; const unsigned long long lt = (1ull << lane) - 1ull;
    int base = 0, r_lo = 0, r_hi = 0;
    for (int c = 0; c < 16; ++c) { const unsigned long long mlo = __ballot(c_lo == c), mhi = __ballot(c_hi == c); const int nlo = (int)__builtin_popcountll(mlo);
        if (c_lo == c) r_lo = base + (int)__builtin_popcountll(mlo & lt);
        if (c_hi == c) r_hi = base + nlo + (int)__builtin_popcountll(mhi & lt);
        base += nlo + (int)__builtin_popcountll(mhi); }
    ((LAS int*)wl)[X * 128 + ((r_lo & ~7) | ((r_lo & 1) << 2) | ((r_lo >> 1) & 3))] = e_lo & EMASK; ((LAS int*)wl)[X * 128 + ((r_hi & ~7) | ((r_hi & 1) << 2) | ((r_hi >> 1) & 3))] = e_hi & EMASK;
    ((LAS float*)(wl + 1024))[X * 128 + r_lo] = g_lo; ((LAS float*)(wl + 1024))[X * 128 + r_hi] = g_hi;
}
__device__ __forceinline__ void expert_selector_table(LAS unsigned char* selT, int tid) {
    const int c = tid >> 5, m = tid & 31; const unsigned code = ((unsigned)(c >> 3) << 5) | 8u | (unsigned)(c & 7); const int pos = 6 * m, w0 = pos >> 5, sh = pos & 31;
    const unsigned lo = code << sh, hi = (sh > 26) ? (code >> (32 - sh)) : 0u; unsigned d[8];
#pragma unroll
    for (int w = 0; w < 8; ++w) d[w] = ((w == w0) ? lo : 0u) | ((w == w0 + 1) ? hi : 0u);
    *(LAS u32x4*)(selT + tid * 32) = (u32x4){d[0], d[1], d[2], d[3]}; *(LAS u32x4*)(selT + tid * 32 + 16) = (u32x4){d[4], d[5], d[6], d[7]};
}
template <int EMASK = 0xffff> __device__ __forceinline__ void expert_mfma4(int tA0, int tB0, int tA1, int tB1, const bf16_t* HN, const unsigned char* U8, const unsigned char* V8, const int* IDX, const float* GS, const float* SSQ, float* out, int lane, LAS unsigned char* hq, const LAS unsigned char* selT, LAS unsigned char* wl) {
    const rsrc_t ur = __builtin_amdgcn_make_buffer_rsrc((void*)U8, 0, 16 << 20, 0x00020000), vr = __builtin_amdgcn_make_buffer_rsrc((void*)V8, 0, 16 << 20, 0x00020000);
    const int h = lane >> 5, l31 = lane & 31, cb = l31 * 16;
    const int r = lane & 15, kb = lane >> 4, sl = r & 3, ca = 64 * kb + 16 * sl;
    const int tme0 = h ? tB0 : tA0, tme1 = h ? tB1 : tA1;
    const int e0[4] = {IDX[(size_t)tA0 * 128 + lane], IDX[(size_t)tA0 * 128 + 64 + lane], IDX[(size_t)tB0 * 128 + lane], IDX[(size_t)tB0 * 128 + 64 + lane]};
    const int e1[4] = {IDX[(size_t)tA1 * 128 + lane], IDX[(size_t)tA1 * 128 + 64 + lane], IDX[(size_t)tB1 * 128 + lane], IDX[(size_t)tB1 * 128 + 64 + lane]};
    const float g0[4] = {GS[(size_t)tA0 * 128 + lane], GS[(size_t)tA0 * 128 + 64 + lane], GS[(size_t)tB0 * 128 + lane], GS[(size_t)tB0 * 128 + 64 + lane]};
    const float g1[4] = {GS[(size_t)tA1 * 128 + lane], GS[(size_t)tA1 * 128 + 64 + lane], GS[(size_t)tB1 * 128 + lane], GS[(size_t)tB1 * 128 + 64 + lane]};
    const f32x4* sp0 = (const f32x4*)(SSQ + (size_t)tme0 * 16); const f32x4 sq0 = (sp0[0] + sp0[1]) + (sp0[2] + sp0[3]);
    const f32x4* sp1 = (const f32x4*)(SSQ + (size_t)tme1 * 16); const f32x4 sq1 = (sp1[0] + sp1[1]) + (sp1[2] + sp1[3]);
    u32x2 hw0[8], hw1[8];
    { const u32x2* hp0 = (const u32x2*)(HN + (size_t)tme0 * 1024 + 4 * l31); const u32x2* hp1 = (const u32x2*)(HN + (size_t)tme1 * 1024 + 4 * l31);
#pragma unroll
      for (int k = 0; k < 8; ++k) { hw0[k] = hp0[32 * k]; hw1[k] = hp1[32 * k]; } }
    f32x16 acc0A, acc0B, acc1A, acc1B;
#define EM_ACCIN(ACCA, ACCB, HW) do { _Pragma("unroll") for (int rq = 0; rq < 4; ++rq) { \
        const unsigned ox_ = h ? HW[2 * rq + 1][0] : HW[2 * rq][0], oy_ = h ? HW[2 * rq + 1][1] : HW[2 * rq][1], sx_ = h ? HW[2 * rq][0] : HW[2 * rq + 1][0], sy_ = h ? HW[2 * rq][1] : HW[2 * rq + 1][1]; \
        auto rx_ = __builtin_amdgcn_permlane32_swap(sx_, sx_, false, false); auto ry_ = __builtin_amdgcn_permlane32_swap(sy_, sy_, false, false); \
        const unsigned px_ = h ? rx_[0] : rx_[1], py_ = h ? ry_[0] : ry_[1];              \
        const unsigned ax_ = h ? px_ : ox_, ay_ = h ? py_ : oy_, bx_ = h ? ox_ : px_, by_ = h ? oy_ : py_;        \
        ACCA[4 * rq] = __uint_as_float(ax_ << 16); ACCA[4 * rq + 1] = __uint_as_float(ax_ & 0xffff0000u); ACCA[4 * rq + 2] = __uint_as_float(ay_ << 16); ACCA[4 * rq + 3] = __uint_as_float(ay_ & 0xffff0000u); \
        ACCB[4 * rq] = __uint_as_float(bx_ << 16); ACCB[4 * rq + 1] = __uint_as_float(bx_ & 0xffff0000u); ACCB[4 * rq + 2] = __uint_as_float(by_ << 16); ACCB[4 * rq + 3] = __uint_as_float(by_ & 0xffff0000u); } } while (0)
    EM_ACCIN(acc0A, acc0B, hw0); EM_ACCIN(acc1A, acc1B, hw1);
#undef EM_ACCIN
    expert_lists<EMASK>(0, e0[0], e0[1], g0[0], g0[1], lane, wl); expert_lists<EMASK>(1, e0[2], e0[3], g0[2], g0[3], lane, wl);
    expert_lists<EMASK>(0, e1[0], e1[1], g1[0], g1[1], lane, wl + 2048); expert_lists<EMASK>(1, e1[2], e1[3], g1[2], g1[3], lane, wl + 2048);
    u32x4 b40[2], b41[2]; u32x2 b20[2], b21[2];
#define EM_HB(HW, SQ, B4, B2) do { f32x16 ev, od; const float hs_ = 2.f * __builtin_amdgcn_rsqf(((SQ[0] + SQ[1]) + (SQ[2] + SQ[3])) * (1.f / 1024.f) + EPS); \
      _Pragma("unroll") for (int k = 0; k < 8; ++k) { const u32x2 w = HW[k]; ev[2 * k] = __builtin_amdgcn_fmed3f(hs_ * __uint_as_float(w[0] << 16), -7.5f, 7.5f); od[2 * k] = __builtin_amdgcn_fmed3f(hs_ * __uint_as_float(w[0] & 0xffff0000u), -7.5f, 7.5f); \
          ev[2 * k + 1] = __builtin_amdgcn_fmed3f(hs_ * __uint_as_float(w[1] << 16), -7.5f, 7.5f); od[2 * k + 1] = __builtin_amdgcn_fmed3f(hs_ * __uint_as_float(w[1] & 0xffff0000u), -7.5f, 7.5f); } \
      const u32x6 pk = __builtin_amdgcn_cvt_scalef32_2xpk16_fp6_f32(ev, od, 1.0f); \
      asm volatile("s_waitcnt lgkmcnt(0)" ::: "memory"); \
      *(LAS u32x4*)(hq + (h * 32 + l31) * 32) = (u32x4){pk[0], pk[1], pk[2], pk[3]}; *(LAS u32x2*)(hq + (h * 32 + l31) * 32 + 16) = (u32x2){pk[4], pk[5]}; \
      asm volatile("s_waitcnt lgkmcnt(0)" ::: "memory"); \
      _Pragma("unroll") for (int j = 0; j < 2; ++j) { const LAS unsigned char* bp = hq + ((((r >> 2) & 1) * 32) + 16 * j + 4 * kb + sl) * 32; B4[j] = *(const LAS u32x4*)bp; B2[j] = *(const LAS u32x2*)(bp + 16); } \
      asm volatile("s_waitcnt lgkmcnt(0)" ::: "memory"); } while (0)
    EM_HB(hw0, sq0, b40, b20); EM_HB(hw1, sq1, b41, b21);
#undef EM_HB
    u32x4 a4[8], vb[8];
    const LAS unsigned char* idA = wl + ((r >> 3) * 128 + ((r >> 2) & 1) * 4) * 4;
    const LAS unsigned char* idV0 = wl + (h * 4) * 4, * idV1 = wl + (128 + h * 4) * 4;
    const LAS unsigned char* gtp = wl + 1024 + (((lane >> 3) & 1) * 128 + (lane & 7)) * 4;
    LAS int* const pks = (LAS int*)(wl + 4096);
#define EM_LOADA(tk, LB) do { const u32x4 ia_ = *(const LAS u32x4*)(idA + (LB) + 32 * (tk)); _Pragma("unroll") for (int g = 0; g < 4; ++g) { const int ro_ = (int)((ia_[g] << 9) | (unsigned)ca); \
        _Pragma("unroll") for (int j = 0; j < 2; ++j) a4[2 * g + j] = __builtin_amdgcn_raw_buffer_load_b128(ur, ro_ + 256 * j, 0, 0); } } while (0)
#define EM_LOADV2(X, g, IV) do { vb[4 * (X) + (g)] = __builtin_amdgcn_raw_buffer_load_b128(vr, (int)((IV[g] << 9) | (unsigned)cb), 0, 0); } while (0)
#define EM_VMFMA(X, g, ACC) do { const int pk_ = pkc[4 * (X) + (g)]; const LAS unsigned char* sp_ = selT + (((unsigned)pk_ >> 8) & 15u) * 1024 + l31 * 32; const u32x4 s4_ = *(const LAS u32x4*)sp_; const u32x2 s2_ = *(const LAS u32x2*)(sp_ + 16); \
        const i32x8 As_ = {(int)s4_[0], (int)s4_[1], (int)s4_[2], (int)s4_[3], (int)s2_[0], (int)s2_[1], 0, 0}, Bv_ = {(int)vb[4 * (X) + (g)][0], (int)vb[4 * (X) + (g)][1], (int)vb[4 * (X) + (g)][2], (int)vb[4 * (X) + (g)][3], 0, 0, 0, 0}; \
        ACC = __builtin_amdgcn_mfma_scale_f32_32x32x64_f8f6f4(As_, Bv_, ACC, 2, 4, 0, pk_, 0, 0x7F7F7F7F); } while (0)
#define EM_VGROUP(g, PA, PB) do { EM_VMFMA(0, g, PA); EM_VMFMA(1, g, PB); asm volatile("" : "+v"(PA), "+v"(PB)); } while (0)
#define EM_STEP(tk, LB, B4, B2, PA, PB, NTK, NLB) do { \
        __builtin_amdgcn_s_barrier();       \
        float pd[4]; \
        _Pragma("unroll") for (int g = 0; g < 4; ++g) { f32x4 c = {0.f, 0.f, 0.f, 0.f}; \
            _Pragma("unroll") for (int j = 0; j < 2; ++j) { const i32x8 A = {(int)a4[2 * g + j][0], (int)a4[2 * g + j][1], (int)a4[2 * g + j][2], (int)a4[2 * g + j][3], 0, 0, 0, 0}, Bm = {(int)B4[j][0], (int)B4[j][1], (int)B4[j][2], (int)B4[j][3], (int)B2[j][0], (int)B2[j][1], 0, 0}; \
                c = __builtin_amdgcn_mfma_scale_f32_16x16x128_f8f6f4(A, Bm, c, 4, 2, 0, 0x7F7F7F7F, 0, 0x7E7E7E7E); } \
            pd[g] = (lane & 2) ? ((lane & 1) ? c[3] : c[2]) : ((lane & 1) ? c[1] : c[0]); } \
        asm volatile("" : "+v"(pd[0]), "+v"(pd[1]), "+v"(pd[2]), "+v"(pd[3])); \
        EM_LOADA(NTK, NLB); \
        const u32x4 iv0_ = *(const LAS u32x4*)(idV0 + (LB) + 32 * (tk)), iv1_ = *(const LAS u32x4*)(idV1 + (LB) + 32 * (tk)); const float gk_ = *(const LAS float*)(gtp + (LB) + 32 * (tk)); \
        _Pragma("unroll") for (int g = 0; g < 4; ++g) { pd[g] += dpp_mov<0xB1>(pd[g]); pd[g] += dpp_mov<0x4E>(pd[g]); } \
        const int sl_ = ((lane >> 3) & 1) * 36 + (lane & 1) * 16; \
        const float x0 = __shfl(pd[0], sl_), x1 = __shfl(pd[1], sl_), x2 = __shfl(pd[2], sl_), x3 = __shfl(pd[3], sl_); \
        __builtin_amdgcn_sched_barrier(0); \
        EM_VGROUP(0, PA, PB); EM_LOADV2(0, 0, iv0_); EM_LOADV2(1, 0, iv1_); \
        __builtin_amdgcn_sched_barrier(0); \
        const float dot_ = (lane & 4) ? ((lane & 2) ? x3 : x2) : ((lane & 2) ? x1 : x0); \
        const float act_ = gelu_tanh(dot_ * (1.f / SU)) * gk_ * (1.f / SV); \
        __builtin_amdgcn_sched_barrier(0); \
        EM_VGROUP(1, PA, PB); EM_LOADV2(0, 1, iv0_); EM_LOADV2(1, 1, iv1_); \
        __builtin_amdgcn_sched_barrier(0); \
        { const unsigned ab_ = __float_as_uint(act_), rb_ = (ab_ & 0x7fffffffu) + (1u << 19); pks[pkslot] = (int)((rb_ >> 23) | ((ab_ >> 31) << 11) | (((rb_ >> 20) & 7u) << 8)); } \
        __builtin_amdgcn_sched_barrier(0); \
        EM_VGROUP(2, PA, PB); EM_LOADV2(0, 2, iv0_); EM_LOADV2(1, 2, iv1_); \
        __builtin_amdgcn_sched_barrier(0); \
        asm volatile("s_waitcnt lgkmcnt(0)" ::: "memory"); \
        const u32x4 q0_ = *(const LAS u32x4*)(pks + 8 * h), q1_ = *(const LAS u32x4*)(pks + 8 * h + 4); \
        __builtin_amdgcn_sched_barrier(0); \
        EM_VGROUP(3, PA, PB); EM_LOADV2(0, 3, iv0_); EM_LOADV2(1, 3, iv1_); \
        __builtin_amdgcn_sched_barrier(0); \
        asm volatile("s_waitcnt lgkmcnt(0)" ::: "memory"); \
        _Pragma("unroll") for (int i = 0; i < 4; ++i) { pkc[i] = (int)q0_[i]; pkc[4 + i] = (int)q1_[i]; } } while (0)
    int pkc[8];
#pragma unroll
    for (int i = 0; i < 8; ++i) pkc[i] = 0;
    const int pkslot = (lane & 1) * 8 + ((lane >> 3) & 1) * 4 + ((lane >> 1) & 3) + 32 * (lane >> 4);
    asm volatile("s_waitcnt lgkmcnt(0)" ::: "memory");
    EM_LOADA(0, 0);
    { const u32x4 iv0_ = *(const LAS u32x4*)idV0, iv1_ = *(const LAS u32x4*)idV1; EM_LOADV2(0, 0, iv0_); EM_LOADV2(1, 0, iv1_); EM_LOADV2(0, 1, iv0_); EM_LOADV2(1, 1, iv1_); EM_LOADV2(0, 2, iv0_); EM_LOADV2(1, 2, iv1_); EM_LOADV2(0, 3, iv0_); EM_LOADV2(1, 3, iv1_); }
#pragma unroll 1
    for (int tk = 0; tk < 16; ++tk) {
        EM_STEP(tk, 0, b40, b20, acc1A, acc1B, tk, 2048);
        EM_STEP(tk, 2048, b41, b21, acc0A, acc0B, (tk + 1) & 15, 0);
    }
    EM_VGROUP(0, acc1A, acc1B); EM_VGROUP(1, acc1A, acc1B); __builtin_amdgcn_sched_barrier(0); EM_VGROUP(2, acc1A, acc1B); EM_VGROUP(3, acc1A, acc1B);
#undef EM_STEP
#undef EM_LOADA
#undef EM_LOADV2
#undef EM_VMFMA
#undef EM_VGROUP
#define EM_ACCOUT(ACC, T) do { const int to_ = (EMASK == 0xffff) ? (T) : ((T) & 16383); f32x4* o_ = (f32x4*)(out + (size_t)to_ * 1024 + 128 * h + 4 * l31); \
        _Pragma("unroll") for (int rq = 0; rq < 4; ++rq) o_[64 * rq] = (f32x4){ACC[4 * rq], ACC[4 * rq + 1], ACC[4 * rq + 2], ACC[4 * rq + 3]}; } while (0)
    EM_ACCOUT(acc0A, tA0); EM_ACCOUT(acc0B, tB0); EM_ACCOUT(acc1A, tA1); EM_ACCOUT(acc1B, tB1);
#undef EM_ACCOUT
}
}
constexpr int NWAVES = 8, NTHREADS = 512;
constexpr int RING_BYTES = 131072;
constexpr int LDS_BYTES = 147456;
constexpr int NPH = 11;

#ifndef DUP_MASK
#define DUP_MASK 0
#endif
#define RLX_AGENT __ATOMIC_RELAXED, __HIP_MEMORY_SCOPE_AGENT
#define XB_TMO      128
#define XB_XCNT(j)  (256  + 64 * (j))
#define XB_XSUB(j)  (1280 + 64 * (j))
#define XB_XGEN(j)  (2304 + 64 * (j))
#define XB_TOP      3328
#define XB_TOPGEN   3392
#define XCD_BAR_WORDS 3456
#define XB_SPIN_CAP (1u << 18)

__device__ __forceinline__ unsigned xb_ld(unsigned* p)              { return __hip_atomic_load(p, __ATOMIC_RELAXED, __HIP_MEMORY_SCOPE_AGENT); }
__device__ __forceinline__ unsigned xb_add(unsigned* p, unsigned v) { return __hip_atomic_fetch_add(p, v, __ATOMIC_RELAXED, __HIP_MEMORY_SCOPE_AGENT); }
__device__ __forceinline__ unsigned xb_xcc_id() { return (unsigned)__builtin_amdgcn_s_getreg((3 << 11) | 20) & 0xFu; }
#define XB_SPIN(cond, bar) do { unsigned _sp = 0; while (cond) { __builtin_amdgcn_s_sleep(1); \
    if ((++_sp & 255u) == 0u) { if (xb_ld(&(bar)[XB_TMO])) break; if (_sp > XB_SPIN_CAP) { atomicAdd(&(bar)[XB_TMO], 1u); break; } } } } while (0)

struct XcdBarrier {
    unsigned* bar; unsigned x;
    volatile LAS unsigned* st;
};

__device__ __forceinline__ XcdBarrier xcd_barrier_post(unsigned* bar, volatile LAS unsigned* st) {
    XcdBarrier b; b.bar = bar; b.x = xb_xcc_id(); b.st = st;
    if (threadIdx.x == 0) (void)xb_add(&bar[XB_XCNT(b.x)], 1u);
    return b;
}
__device__ __forceinline__ void xcd_barrier_complete(unsigned* bar, unsigned x, unsigned& nloc, unsigned& nx) {
    const unsigned G = gridDim.x * gridDim.y * gridDim.z;
    unsigned sum, cnt, mine, sp = 0u;
    for (;;) {
        sum = 0u; cnt = 0u; mine = 0u;
#pragma unroll
        for (unsigned j = 0; j < 16; ++j) { const unsigned c = xb_ld(&bar[XB_XCNT(j)]); sum += c; cnt += (c > 0u) ? 1u : 0u; mine = (j == x) ? c : mine; }
        if (sum == G) break;
        __builtin_amdgcn_s_sleep(1);
        if ((++sp & 255u) == 0u) { if (xb_ld(&bar[XB_TMO])) break; if (sp > XB_SPIN_CAP) { atomicAdd(&bar[XB_TMO], 1u); break; } }
    }
    nloc = mine > 0u ? mine : 1u; nx = cnt > 0u ? cnt : 1u;
}

__device__ __forceinline__ void xcd_barrier(const XcdBarrier& b) {
    asm volatile("s_waitcnt vmcnt(0)" ::: "memory");
    __syncthreads();
    if (threadIdx.x == 0) {
        unsigned* bar = b.bar;
        __builtin_amdgcn_s_waitcnt(0);
        unsigned nloc = b.st[0], nx = b.st[1];
        if (nloc == 0u) { xcd_barrier_complete(bar, b.x, nloc, nx); b.st[0] = nloc; b.st[1] = nx; }
        const unsigned old = xb_add(&bar[XB_XSUB(b.x)], 1u);
        const unsigned gen = old / nloc;
        if (old + 1u == (gen + 1u) * nloc) {
            __builtin_amdgcn_fence(__ATOMIC_RELEASE, "agent");
            asm volatile("s_waitcnt vmcnt(0)" ::: "memory");
            const unsigned og = xb_add(&bar[XB_TOP], 1u);
            const unsigned tg = og / nx;
            if (og + 1u == (tg + 1u) * nx) xb_add(&bar[XB_TOPGEN], 1u);
            else XB_SPIN(xb_ld(&bar[XB_TOPGEN]) == tg, bar);
            __builtin_amdgcn_fence(__ATOMIC_ACQUIRE, "agent");
            xb_add(&bar[XB_XGEN(b.x)], 1u);
            asm volatile("s_waitcnt vmcnt(0)" ::: "memory");
        } else {
            XB_SPIN(xb_ld(&bar[XB_XGEN(b.x)]) == gen, bar);
            __builtin_amdgcn_fence(__ATOMIC_ACQUIRE, "agent");
            asm volatile("s_waitcnt vmcnt(0)" ::: "memory");
        }
    }
    __syncthreads();
}
constexpr int MISC_OFF = LDS_BYTES - 64;
struct Args { const float* in[21]; float* out; unsigned char* ws; int ph_lo, ph_hi, dup, pad; };

struct Frame { LAS unsigned char* lds; int tid, lane, wave, G, vcu, gw, NGW; };

#define LDS_WAIT() asm volatile("s_waitcnt lgkmcnt(0)" ::: "memory")

__device__ __forceinline__ void p0_transpose_item(const float* W, int ldw, int skip_at, int skip, bf16_t* WT, int ldo, int koff, int nblk, LAS float* scr, int item, int lane, const float* kscale = nullptr) {
    const int kb = item / nblk, nb = item % nblk, k0 = 64 * kb, n0 = 32 * nb;
    const int nsrc = n0 + (lane & 31) + ((n0 >= skip_at) ? skip : 0);
#pragma unroll 8
    for (int i = 0; i < 32; ++i) { const int kk = 2 * i + (lane >> 5); float w_ = W[(size_t)(k0 + kk) * ldw + nsrc]; if (kscale) w_ *= kscale[k0 + kk]; scr[kk * 33 + (lane & 31)] = w_; }
    LDS_WAIT(); asm volatile("" ::: "memory");
    const int c = lane & 7;
#pragma unroll
    for (int j = 0; j < 4; ++j) { const int n = (lane >> 3) + 8 * j; const LAS float* s = scr + (8 * c) * 33 + n;
        u32x4 o; o.x = pk2(s[0 * 33], s[1 * 33]); o.y = pk2(s[2 * 33], s[3 * 33]); o.z = pk2(s[4 * 33], s[5 * 33]); o.w = pk2(s[6 * 33], s[7 * 33]);
        *(u32x4*)(WT + (size_t)(n0 + n) * ldo + koff + k0 + 8 * c) = o; }
    LDS_WAIT(); asm volatile("" ::: "memory");
}

__device__ __forceinline__ void norm_rows4(const float* src, const float* gain, bf16_t* dst, int gw, int NGW, int lane) {
    f32x4 gv[4];
#pragma unroll
    for (int j = 0; j < 4; ++j) gv[j] = ((const f32x4*)gain)[lane + 64 * j];
    for (int row0 = gw * 4; row0 < T_; row0 += NGW * 4) {
        f32x4 v[4][4]; float ss[4];
#pragma unroll
        for (int r = 0; r < 4; ++r) { const f32x4* xr = (const f32x4*)(src + (size_t)(row0 + r) * D_);
#pragma unroll
            for (int j = 0; j < 4; ++j) v[r][j] = xr[lane + 64 * j]; }
#pragma unroll
        for (int r = 0; r < 4; ++r) { ss[r] = 0.f;
#pragma unroll
            for (int j = 0; j < 4; ++j) ss[r] += v[r][j].x * v[r][j].x + v[r][j].y * v[r][j].y + v[r][j].z * v[r][j].z + v[r][j].w * v[r][j].w; }
#pragma unroll
        for (int o = 1; o < 64; o <<= 1) {
#pragma unroll
            for (int r = 0; r < 4; ++r) ss[r] += __shfl_xor(ss[r], o); }
#pragma unroll
        for (int r = 0; r < 4; ++r) { const float rstd = rsqrtf(ss[r] * (1.f / D_) + EPS);
#pragma unroll
            for (int j = 0; j < 4; ++j) { const f32x4 w = v[r][j] * rstd * gv[j]; u32x2 o; o.x = pk2(w.x, w.y); o.y = pk2(w.z, w.w); ((u32x2*)(dst + (size_t)(row0 + r) * D_))[lane + 64 * j] = o; } }
    }
}

template <bool G2> __device__ __forceinline__ void fp4_table(const f32x4* src, const f32x4* g2v, unsigned char* dst, float sc, int gt, int NGT) {
    for (int i = gt; i < 16384 * 32; i += NGT) { const int row = i >> 5, j = i & 31; f32x4 v[8];
#pragma unroll
        for (int k = 0; k < 8; ++k) v[k] = src[(size_t)row * 256 + 32 * k + j];
        if (G2) {
#pragma unroll
            for (int k = 0; k < 8; ++k) v[k] = v[k] * g2v[32 * k + j]; }
        u32x4 pk = {0u, 0u, 0u, 0u};
#pragma unroll
        for (int w = 0; w < 4; ++w) { unsigned x = 0u;
            x = __builtin_amdgcn_cvt_scalef32_pk_fp4_f32(x, v[2 * w][0] * sc, v[2 * w][1] * sc, 1.0f, 0); x = __builtin_amdgcn_cvt_scalef32_pk_fp4_f32(x, v[2 * w][2] * sc, v[2 * w][3] * sc, 1.0f, 1);
            x = __builtin_amdgcn_cvt_scalef32_pk_fp4_f32(x, v[2 * w + 1][0] * sc, v[2 * w + 1][1] * sc, 1.0f, 2); x = __builtin_amdgcn_cvt_scalef32_pk_fp4_f32(x, v[2 * w + 1][2] * sc, v[2 * w + 1][3] * sc, 1.0f, 3); pk[w] = x; }
        *(u32x4*)(dst + (size_t)row * 512 + 16 * j) = pk; }
}
__device__ __forceinline__ void phase0(const Frame& F, const Args& a) {
    unsigned char* ws = a.ws;
    const float* x = a.in[0]; const float* g1 = a.in[1]; const float* w_in = a.in[2];
    {
        LAS float* scr = (LAS float*)(F.lds + F.wave * 16384);
        constexpr int I_IN = 16 * 176, I_UPN = 8 * 32, I_UPD = 4 * 32, I_O = 16 * 32, I_Q = 16 * 32, I_C1 = 32 * 8;
        constexpr int NITEMS = I_IN + I_UPN + I_UPD + I_O + I_Q + 2 * I_C1;
        for (int it = F.gw; it < NITEMS; it += F.NGW) {
            int r = it;
            if (r < I_IN) { p0_transpose_item(w_in, IN_COLS, 1280, 24, (bf16_t*)(ws + WS_WTIN), 1024, 0, 176, scr, r, F.lane); continue; } r -= I_IN;
            if (r < I_UPN) { p0_transpose_item(a.in[13], 1024, 1 << 30, 0, (bf16_t*)(ws + WS_WTCAT), YP, 0, 32, scr, r, F.lane); continue; } r -= I_UPN;
            if (r < I_UPD) { p0_transpose_item(a.in[14], 1024, 1 << 30, 0, (bf16_t*)(ws + WS_WTCAT), YP, 512, 32, scr, r, F.lane); continue; } r -= I_UPD;
            if (r < I_O) { p0_transpose_item(a.in[15], 1024, 1 << 30, 0, (bf16_t*)(ws + WS_WTO), 1024, 0, 32, scr, r, F.lane); continue; } r -= I_O;
            if (r < I_Q) { p0_transpose_item(a.in[17], 1024, 1 << 30, 0, (bf16_t*)(ws + WS_WTQ), 1024, 0, 32, scr, r, F.lane, a.in[16]); continue; } r -= I_Q;
            if (r < I_C1) { p0_transpose_item(a.in[6], 256, 1 << 30, 0, (bf16_t*)(ws + WS_WTC1K), 2048, 0, 8, scr, r, F.lane); continue; } r -= I_C1;
            p0_transpose_item(a.in[9], 256, 1 << 30, 0, (bf16_t*)(ws + WS_WTC1V), 2048, 0, 8, scr, r, F.lane);
        }
    }
    {
        const int gt = F.vcu * NTHREADS + F.tid, NGT = F.G * NTHREADS;
        float* rope = (float*)(ws + WS_ROPE);
        for (int id = gt; id < S_ * 8; id += NGT) {
            const int pos = id >> 3, i = id & 7;
            const float inv = (float)pow(500000.0, -(double)i / 8.0);
            const float ang = (float)pos * inv;
            const double rev = (double)ang * 0.15915494309189535;
            const double fr = rev - floor(rev);
            const float aa = (float)(fr * 6.283185307179586);
            rope[pos * 16 + i] = __cosf(aa); rope[pos * 16 + 8 + i] = __sinf(aa);
        }
        bf16_t* sk = (bf16_t*)(ws + WS_SUBK); const float* subkeys = a.in[18];
        for (int id = gt; id < 2 * 128 * 64; id += NGT) { const int c = id >> 13, n = (id >> 6) & 127, d = id & 63; sk[(size_t)c * 8192 + (d >> 3) * 1024 + n * 8 + (d & 7)] = f2bf(subkeys[id]); }
        const int task = F.NGW - 1 - F.gw;
        if (task < 256) { const int which = task >> 7, kc = (task >> 2) & 31, n = (task & 3) * 64 + F.lane; const float* pe = (which ? a.in[8] : a.in[5]) + kc * 64; const float* w1 = (which ? a.in[9] : a.in[6]) + (size_t)kc * 64 * 256 + n;
            float s0 = 0.f, s1 = 0.f, s2 = 0.f, s3 = 0.f;
#pragma unroll
            for (int k = 0; k < 64; k += 4) { s0 += pe[k] * w1[(size_t)k * 256]; s1 += pe[k + 1] * w1[(size_t)(k + 1) * 256]; s2 += pe[k + 2] * w1[(size_t)(k + 2) * 256]; s3 += pe[k + 3] * w1[(size_t)(k + 3) * 256]; }
            ((float*)(ws + WS_BIAS1))[(which * 32 + kc) * 256 + n] = (s0 + s1) + (s2 + s3); }
        { float* gt_ = (float*)(ws + WS_GAINS); for (int id = gt; id < 640; id += NGT) gt_[id] = (id < 64) ? a.in[3][id] : (id < 256) ? a.in[4][id - 64] : (id < 448) ? a.in[11][id - 256] : a.in[12][id - 448]; }
        bf16_t* w2t = (bf16_t*)(ws + WS_W2T);
        for (int id = gt; id < 2 * 64 * 256; id += NGT) { const int which = id >> 14, d = (id >> 8) & 63, n = id & 255; w2t[id] = f2bf((which ? a.in[10] : a.in[7])[n * 64 + d]); }
    }
    {
        const int gt = F.vcu * NTHREADS + F.tid, NGT = F.G * NTHREADS;
        fp4_table<true>((const f32x4*)a.in[19], (const f32x4*)a.in[16], ws + WS_U, peer::SU, gt, NGT);
        fp4_table<false>((const f32x4*)a.in[20], (const f32x4*)a.in[16], ws + WS_U + 16 * MiB, peer::SV, gt, NGT);
    }
    {
        const int gt = F.vcu * NTHREADS + F.tid, NGT = F.G * NTHREADS; bf16_t* wgt = (bf16_t*)(ws + WS_WG);
        for (int id = gt; id < 32 * 1024; id += NGT) { const int c = id >> 10, k = id & 1023; wgt[id] = (c < 24) ? f2bf(w_in[(size_t)k * IN_COLS + 1280 + c]) : (bf16_t)0; }
    }
    norm_rows4(x, g1, (bf16_t*)(ws + WS_H), F.gw, F.NGW, F.lane);
}


__device__ __forceinline__ void phase2(const Args& a, LAS unsigned char* lds, int vcu, int G, int wave, int lane) {
    unsigned char* ws = a.ws;
    const bf16_t* KV6 = (const bf16_t*)(ws + WS_KV6);
    const int fr = lane & 15, fq = lane >> 4;
    for (int tp = vcu; tp < 256; tp += G) { const int t2 = tp * 2 + (wave >> 2);
        const int which = t2 >> 8, t = t2 & 255, r0 = (t >> 2) * 64, c0 = (t & 3) * 64, bg = r0 >> 8, i0 = r0 & 255, kq = wave & 3;
        const bf16_t* A = KV6 + (size_t)which * KV6_STRIDE + ((size_t)bg * S_ + 16 * i0) * HD + 512 * kq;
        const bf16_t* Bt = (const bf16_t*)(ws + (which ? WS_WTC1V : WS_WTC1K)) + (size_t)c0 * 2048 + 512 * kq;
        const float* bp1 = (const float*)(ws + WS_BIAS1) + which * 32 * 256 + c0 + fr; bf16_t* HID = (bf16_t*)(ws + WS_HID) + (size_t)which * 4096 * 256;
        float bsum[4] = {0.f, 0.f, 0.f, 0.f};
#pragma unroll
        for (int kc = 0; kc < 32; ++kc) {
#pragma unroll
            for (int ni = 0; ni < 4; ++ni) bsum[ni] += bp1[kc * 256 + 16 * ni]; }
        f32x4 acc[4][4]; ZERO_ACC(acc);
        wave_gemm64(A, 1024, Bt, 2048, 512, acc, lane);
        __syncthreads();
        LAS float* mine = (LAS float*)(lds + wave * 16384) + lane;
#pragma unroll
        for (int mi = 0; mi < 4; ++mi)
#pragma unroll
            for (int ni = 0; ni < 4; ++ni)
#pragma unroll
                for (int j = 0; j < 4; ++j) mine[((mi * 4 + ni) * 4 + j) * 64] = acc[mi][ni][j];
        __syncthreads();
        const LAS float* grp = (const LAS float*)(lds + (wave & 4) * 16384) + lane;
#pragma unroll
        for (int ni = 0; ni < 4; ++ni)
#pragma unroll
            for (int j = 0; j < 4; ++j) { const int e = ((kq * 4 + ni) * 4 + j) * 64;
                const float v = (grp[e] + grp[e + 4096]) + (grp[e + 8192] + grp[e + 12288]);
                const int row = r0 + 16 * kq + 4 * fq + j, col = c0 + 16 * ni + fr;
                HID[(size_t)row * 256 + col] = f2bf(gelu_tanh(v + bsum[ni])); }
    }
    {
        const bf16_t* H = (const bf16_t*)(ws + WS_H); const bf16_t* WG = (const bf16_t*)(ws + WS_WG); float* gates = (float*)(ws + WS_GATES);
        for (int tile = vcu * 8 + wave; tile < T_ / 16; tile += G * 8) {
            const bf16_t* ap = WG + (size_t)fr * 1024 + fq * 8; const bf16_t* bp = H + (size_t)(tile * 16 + fr) * 1024 + fq * 8;
            f32x4 c0 = {0.f, 0.f, 0.f, 0.f}, c1 = c0;
#pragma unroll 8
            for (int ks = 0; ks < 32; ++ks) { const bf16x8 b = *(const bf16x8*)(bp + ks * 32);
                c0 = __builtin_amdgcn_mfma_f32_16x16x32_bf16(*(const bf16x8*)(ap + ks * 32), b, c0, 0, 0, 0);
                c1 = __builtin_amdgcn_mfma_f32_16x16x32_bf16(*(const bf16x8*)(ap + 16 * 1024 + ks * 32), b, c1, 0, 0, 0); }
            float* gp = gates + (size_t)(tile * 16 + fr) * 24 + 4 * fq;
#pragma unroll
            for (int j = 0; j < 4; ++j) { gp[j] = sigmoidf_(c0[j]); if (fq < 2) gp[16 + j] = sigmoidf_(c1[j]); }
        }
    }
}
__device__ __forceinline__ void cmp2_tasks(const Args& a, int gw, int NGW, int lane) {
    unsigned char* ws = a.ws; const float* rope = (const float*)(ws + WS_ROPE); const float* nsa_kn = a.in[4];
    const int fr = lane & 15;
    for (int id = gw; id < 128; id += NGW) {
        const int which = id >> 6, r0 = (id & 63) * 64;
        f32x4 acc[4][4]; ZERO_ACC(acc);
        wave_gemm64((const bf16_t*)(ws + WS_HID) + ((size_t)which * 4096 + r0) * 256, 256, (const bf16_t*)(ws + WS_W2T) + (size_t)which * 64 * 256, 256, 256, acc, lane);
        if (which == 1) {
            bf16_t* VC = (bf16_t*)(ws + WS_VCMP);
            FOR_ACC(acc, r0, 0, lane, VC[(size_t)row * 64 + col] = ((row & 255) < NCMP) ? f2bf(val) : (bf16_t)0; )
        } else {
            bf16_t* KC = (bf16_t*)(ws + WS_KCMP);
#pragma unroll
            for (int mi = 0; mi < 4; ++mi)
#pragma unroll
                for (int j = 0; j < 4; ++j) {
                    const int row = r0 + 16 * mi + 4 * (lane >> 4) + j, i = row & 255;
                    float ss = acc[mi][0][j] * acc[mi][0][j] + acc[mi][1][j] * acc[mi][1][j] + acc[mi][2][j] * acc[mi][2][j] + acc[mi][3][j] * acc[mi][3][j];
                    ss += __shfl_xor(ss, 1); ss += __shfl_xor(ss, 2); ss += __shfl_xor(ss, 4); ss += __shfl_xor(ss, 8);
                    const float rstd = rsqrtf(ss * (1.f / 64.f) + EPS);
                    float z[4];
#pragma unroll
                    for (int ni = 0; ni < 4; ++ni) z[ni] = acc[mi][ni][j] * rstd * nsa_kn[16 * ni + fr];
                    const float pz = __shfl_xor(z[0], 8); const int pos = (16 * i + 31) & 4095;
                    const float c = rope[pos * 16 + (fr & 7)], sn = rope[pos * 16 + 8 + (fr & 7)];
                    z[0] = (fr < 8) ? (z[0] * c - pz * sn) : (pz * sn + z[0] * c);
#pragma unroll
                    for (int ni = 0; ni < 4; ++ni) KC[(size_t)row * 64 + 16 * ni + fr] = (i < NCMP) ? f2bf(z[ni]) : (bf16_t)0;
                }
        }
    }
}
__device__ __forceinline__ void dil_combine(const Args& a, int gt, int NGT) {
    unsigned char* ws = a.ws; const bf16_t* DILO = (const bf16_t*)(ws + WS_DILO); const float* DLSE = (const float*)(ws + WS_DLSE); bf16_t* Y = (bf16_t*)(ws + WS_Y);
    for (int idx = gt; idx < T_ * 32; idx += NGT) {
        const int t = idx >> 5, c = idx & 31, h = c >> 3;
        const float l0 = DLSE[((size_t)0 * T_ + t) * 4 + h], l1 = DLSE[((size_t)1 * T_ + t) * 4 + h], l2 = DLSE[((size_t)2 * T_ + t) * 4 + h];
        const float mx = fmaxf(l0, fmaxf(l1, l2)); float w0 = __builtin_amdgcn_exp2f(l0 - mx), w1 = __builtin_amdgcn_exp2f(l1 - mx), w2 = __builtin_amdgcn_exp2f(l2 - mx);
        const float inv = 1.f / (w0 + w1 + w2); w0 *= inv; w1 *= inv; w2 *= inv;
        const u32x4 o0 = *(const u32x4*)(DILO + ((size_t)0 * T_ + t) * 256 + c * 8), o1 = *(const u32x4*)(DILO + ((size_t)1 * T_ + t) * 256 + c * 8), o2 = *(const u32x4*)(DILO + ((size_t)2 * T_ + t) * 256 + c * 8);
        u32x4 o;
#pragma unroll
        for (int i = 0; i < 4; ++i) {
            const float lo = w0 * __uint_as_float(o0[i] << 16) + w1 * __uint_as_float(o1[i] << 16) + w2 * __uint_as_float(o2[i] << 16);
            const float hi = w0 * __uint_as_float(o0[i] & 0xffff0000u) + w1 * __uint_as_float(o1[i] & 0xffff0000u) + w2 * __uint_as_float(o2[i] & 0xffff0000u);
            o[i] = pk2(lo, hi); }
        *(u32x4*)(Y + (size_t)t * YP + 512 + c * 8) = o;
    }
}
__device__ __forceinline__ void phase7(const Args& a, int gw, int NGW, int lane) { norm_rows4(a.out, a.in[16], (bf16_t*)(a.ws + WS_HN), gw, NGW, lane); }

__global__ void __launch_bounds__(NTHREADS, 2) mega_fwd(Args a) {
    extern __shared__ __attribute__((aligned(16))) unsigned char lds_raw[];
    Frame F;
    F.lds = (LAS unsigned char*)lds_raw;
    F.tid = threadIdx.x; F.lane = F.tid & 63; F.wave = __builtin_amdgcn_readfirstlane(F.tid >> 6);
    F.G = gridDim.x; { const int bx = blockIdx.x; F.vcu = (F.G % 8 == 0) ? (bx % 8) * (F.G / 8) + bx / 8 : bx; }
    F.gw = F.vcu * NWAVES + F.wave; F.NGW = F.G * NWAVES;
    unsigned char* ws = a.ws;
    const int lo = a.ph_lo, hi = a.ph_hi;
#ifndef PHASE_MASK
#define PHASE_MASK 0x7ff
#endif
#define IN(k) (((PHASE_MASK >> (k)) & 1) && lo <= (k) && (k) < hi)
    volatile LAS unsigned* MISC = (volatile LAS unsigned*)(F.lds + MISC_OFF);
    if (F.tid < 16) MISC[F.tid] = 0u;
    unsigned* barw = (unsigned*)(ws + WS_CTL);
    if (IN(0) && blockIdx.x == 0) { for (int i = F.tid; i < XCD_BAR_WORDS; i += NTHREADS) __hip_atomic_store(barw + i, 0u, RLX_AGENT); }
    __syncthreads();
    XcdBarrier bar; bar.bar = barw; bar.x = 0; bar.st = MISC;
#define SEAM(k) do { if (IN(k) && IN((k) + 1)) { if ((k) == 0) { cg::this_grid().sync(); bar = xcd_barrier_post(barw, MISC); } else xcd_barrier(bar); } } while (0)

#define DUPQ(k) ((DUP_MASK >> (k)) & 1)
#define RUN(k, ...) do { if (IN(k)) { __VA_ARGS__ if constexpr (DUPQ(k)) { xcd_barrier(bar); __VA_ARGS__ } } } while (0)
    if (IN(0)) { phase0(F, a); if constexpr (DUPQ(0)) { __syncthreads(); phase0(F, a); } } SEAM(0);
#define P1_BODY { pg8::Gemm g{(const bf16_t*)(ws + WS_H), (const bf16_t*)(ws + WS_WTIN), T_, NIN, D_}; pg8::StaticOrder S; S.init(T_, NIN, F.G, (int)blockIdx.x); \
        pg8::EpiInproj E{ws, (bf16_t*)a.out, -1, (LAS float*)(F.lds + RING_BYTES)}; \
        pg8::gemm_phase<pg8::EpiInproj, pg8::StaticOrder, true, true>(F.lds, g, S, E); }
    RUN(1, P1_BODY); SEAM(1);
    RUN(2, phase2(a, F.lds, F.vcu, F.G, F.wave, F.lane); ); SEAM(2);
    RUN(3,
        cmp2_tasks(a, F.gw, F.NGW, F.lane);
        for (int uid = F.vcu; uid < 1536; uid += F.G) { const int sub = uid & 15, h = (uid >> 4) & 3, bg = uid >> 6, g = bg % 3, b = bg / 3;
            const int res = (g == 0) ? 0 : (g == 1 ? (sub & 3) : sub), lb = (g == 0) ? sub : (g == 1 ? (sub >> 2) : 0);
            att::dil_unit(F.lds, b, g, h, res, lb, (const bf16_t*)(ws + WS_DIL), (bf16_t*)(ws + WS_DILO), (float*)(ws + WS_DLSE), F.wave, F.lane); } ); SEAM(3);
    RUN(4,
        dil_combine(a, F.vcu * NTHREADS + F.tid, F.G * NTHREADS);
        for (int i = F.vcu; i < 1024; i += F.G) { const int k = i >> 8, v = i & 255, bgi = v >> 4, s = v & 15;
            const int n = (k == 0) ? s : (k == 1) ? 63 - s : (k == 2) ? 16 + s : 47 - s;
            att::nsa_unit(F.lds, bgi >> 1, bgi & 1, n, (const bf16_t*)(ws + WS_QN), (const bf16_t*)(ws + WS_KV6), (const bf16_t*)(ws + WS_KCMP), (const bf16_t*)(ws + WS_VCMP), (const float*)(ws + WS_GATES), (bf16_t*)(ws + WS_Y), F.wave, F.lane); } ); SEAM(4);
    RUN(5, { pg8::Gemm g{(const bf16_t*)(ws + WS_Y), (const bf16_t*)(ws + WS_WTCAT), T_, D_, YP}; pg8::StaticOrder S; S.init(T_, D_, F.G, (int)blockIdx.x);
        pg8::EpiMerge E{(const unsigned char*)a.out, (bf16_t*)(ws + WS_MERGED), 8};
        pg8::gemm_phase<pg8::EpiMerge, pg8::StaticOrder, true, true>(F.lds, g, S, E); } ); SEAM(5);
    RUN(6, { pg8::Gemm g{(const bf16_t*)(ws + WS_MERGED), (const bf16_t*)(ws + WS_WTO), T_, D_, D_}; pg8::StaticOrder S; S.init(T_, D_, F.G, (int)blockIdx.x);
        pg8::EpiWo E{a.in[0], a.out, -1, (bf16_t*)(ws + WS_HN), (float*)(ws + WS_SSQ)};
        pg8::gemm_phase<pg8::EpiWo, pg8::StaticOrder, true, true>(F.lds, g, S, E); } ); SEAM(6);
    RUN(8, { pg8::Gemm g{(const bf16_t*)(ws + WS_HN), (const bf16_t*)(ws + WS_WTQ), T_, D_, D_}; pg8::StaticOrder S; S.init(T_, D_, F.G, (int)blockIdx.x);
        pg8::EpiPQ E{(bf16_t*)(ws + WS_PQ), (const float*)(ws + WS_SSQ), -1};
        pg8::gemm_phase<pg8::EpiPQ, pg8::StaticOrder, true, true>(F.lds, g, S, E); } ); SEAM(8);
    RUN(9,
        { const u32x4* src = (const u32x4*)(ws + WS_SUBK); LAS u32x4* dst = (LAS u32x4*)F.lds; for (int i = F.tid; i < 2048; i += NTHREADS) dst[i] = src[i]; }
        __syncthreads();
        for (int u = F.gw; u < 4096; u += F.NGW) peer::route_unit(F.lds, (u >> 2) * 32, u & 3, (const bf16_t*)(ws + WS_PQ), (int*)(ws + WS_IDX), (float*)(ws + WS_GS), F.wave, F.lane); ); SEAM(9);
    if (IN(10)) {
        peer::expert_selector_table((LAS unsigned char*)(F.lds + 98304), F.tid);
        for (int t = F.gw; t + 3 * F.NGW < T_; t += 4 * F.NGW) {
            __syncthreads();
            peer::expert_mfma4(t, t + F.NGW, t + 2 * F.NGW, t + 3 * F.NGW, (const bf16_t*)(ws + WS_HN), (const unsigned char*)(ws + WS_U), (const unsigned char*)(ws + WS_U + 16 * MiB), (const int*)(ws + WS_IDX), (const float*)(ws + WS_GS), (const float*)(ws + WS_SSQ), a.out, F.lane,
                              (LAS unsigned char*)(F.lds + 8192 + F.wave * 2048), (const LAS unsigned char*)(F.lds + 98304), (LAS unsigned char*)(F.lds + 32768 + F.wave * 8192)); }
    }
#undef IN
#undef SEAM
}
#ifndef DUP_MASK
#define DUP_MASK 0
#endif
static int g_grid = 0;
static void launch_mega(const Args& base, int lo, int hi, hipStream_t stream) {
    Args a = base; a.ph_lo = lo; a.ph_hi = hi;
    if (hi - lo > 1) {
        void* args[] = {&a};
        hipError_t e = hipLaunchCooperativeKernel((const void*)mega_fwd, dim3(g_grid), dim3(NTHREADS), args, LDS_BYTES, stream);
        if (e != hipSuccess) fprintf(stderr, "cooperative launch failed: %s (grid %d)\n", hipGetErrorString(e), g_grid);
    } else {
        hipLaunchKernelGGL(mega_fwd, dim3(g_grid), dim3(NTHREADS), LDS_BYTES, stream, a);
    }
}
extern "C" void kernel_launch(void* const* d_in, const int* in_sizes, int n_in, void* d_out, int out_size, void* d_ws, size_t ws_size, hipStream_t stream) {
    if (n_in != 21 || ws_size < WS_END) { fprintf(stderr, "kernel_launch: unexpected n_in %d / ws_size %zu (need %zu)\n", n_in, ws_size, (size_t)WS_END); return; }
    if (g_grid == 0) {
        int dev = 0, cus = 0, per_cu = 0;
        (void)hipGetDevice(&dev); (void)hipDeviceGetAttribute(&cus, hipDeviceAttributeMultiprocessorCount, dev);
        (void)hipFuncSetAttribute((const void*)mega_fwd, hipFuncAttributeMaxDynamicSharedMemorySize, LDS_BYTES);
        (void)hipOccupancyMaxActiveBlocksPerMultiprocessor(&per_cu, (const void*)mega_fwd, NTHREADS, LDS_BYTES);
        if (per_cu < 1) fprintf(stderr, "kernel_launch: occupancy query says %d blocks/CU\n", per_cu);
        (void)hipGetLastError();
        g_grid = cus;
    }
    const float* nsa_qn = (const float*)d_in[3]; const float* nsa_kn = (const float*)d_in[4];
    const float* w2_k = (const float*)d_in[7]; const float* w2_v = (const float*)d_in[10];
    const float* dil_qn = (const float*)d_in[11]; const float* dil_kn = (const float*)d_in[12];
    const float* norm2_g = (const float*)d_in[16]; const float* subkeys = (const float*)d_in[18];
    unsigned char* ws = (unsigned char*)d_ws; float* out = (float*)d_out;
    bf16_t* WTC1K = (bf16_t*)(ws + WS_WTC1K); bf16_t* WTC1V = (bf16_t*)(ws + WS_WTC1V);
    float* ROPE = (float*)(ws + WS_ROPE); float* BIAS1 = (float*)(ws + WS_BIAS1); bf16_t* KCMP = (bf16_t*)(ws + WS_KCMP); bf16_t* VCMP = (bf16_t*)(ws + WS_VCMP);
    bf16_t* HID = (bf16_t*)(ws + WS_HID); float* GATES = (float*)(ws + WS_GATES);
    bf16_t* Y = (bf16_t*)(ws + WS_Y); bf16_t* HN = (bf16_t*)(ws + WS_HN);
    bf16_t* QN = (bf16_t*)(ws + WS_QN); bf16_t* KV6 = (bf16_t*)(ws + WS_KV6); bf16_t* DIL = (bf16_t*)(ws + WS_DIL);
    bf16_t* PQ = (bf16_t*)(ws + WS_PQ); int* IDX = (int*)(ws + WS_IDX); float* GS = (float*)(ws + WS_GS);
    Args a{};
    for (int i = 0; i < 21; ++i) a.in[i] = (const float*)d_in[i];
    a.out = out; a.ws = ws; a.dup = DUP_MASK;

    launch_mega(a, 0, NPH, stream);
}
```
